# Optimizing an MI355X kernel written in HIP

```python
import math
import jax, jax.numpy as jnp
from jax import lax
import numpy as np


D_MODEL = 1024
BATCH = 16
SEQ = 4096
DEPTH = 1

SSD_EXPAND = 2
D_INNER = SSD_EXPAND * D_MODEL
SSD_HEAD_DIM = 64
SSD_HEADS = D_INNER // SSD_HEAD_DIM
SSD_GROUPS = 8
D_STATE = 128
SSD_CONV = 4
SSD_CHUNK = 128
SSD_CONV_DIM = D_INNER + 2 * SSD_GROUPS * D_STATE
SSD_NORM_GROUP = D_INNER // SSD_GROUPS
ATTN_WINDOWS = (128, 512, 2048)
ATTN_DILATIONS = (1, 4, 16)
ATTN_N_GROUPS = 3
ATTN_HEADS_PER_GROUP = 8
ATTN_HEAD_DIM = 64
ATTN_BLOCK = 128
ATTN_WIDTH = ATTN_N_GROUPS * ATTN_HEADS_PER_GROUP * ATTN_HEAD_DIM
ATTN_OUT = ATTN_HEADS_PER_GROUP * ATTN_HEAD_DIM
D_FF = 2816
FFN_CONV = 3
EPS = 1e-6
IN_WIDTHS = (D_INNER, SSD_CONV_DIM, SSD_HEADS, ATTN_WIDTH, ATTN_WIDTH, ATTN_WIDTH, D_MODEL, D_MODEL)
IN_SPLITS = tuple(sum(IN_WIDTHS[:i + 1]) for i in range(len(IN_WIDTHS) - 1))
D_IN_PROJ = sum(IN_WIDTHS)

kernel_name = 'hybrid_ssd_dilated_attn_block'


def rms_norm(x, g):
    xf = x.astype(jnp.float32)
    y = xf * lax.rsqrt(jnp.mean(xf * xf, axis=-1, keepdims=True) + EPS)
    return (y * g.astype(jnp.float32)).astype(x.dtype)


def causal_dwconv(x, w, bias):
    K = w.shape[0]
    s = x.shape[1]
    xp = jnp.pad(x, ((0, 0), (K - 1, 0), (0, 0)))
    out = bias
    for i in range(K):
        out = out + xp[:, i:i + s] * w[i]
    return out


def ssd_chunked(xs, dt, A, Bm, Cm):
    b, s, H, P = xs.shape
    G, N = Bm.shape[2], Bm.shape[3]
    K = H // G
    Q = SSD_CHUNK
    c = s // Q
    X = (xs * dt[..., None]).reshape(b, c, Q, G, K, P)
    a = (dt * A).reshape(b, c, Q, G, K).transpose(0, 1, 3, 4, 2)
    a_cs = jnp.cumsum(a, axis=-1)
    Bc = Bm.reshape(b, c, Q, G, N)
    Cc = Cm.reshape(b, c, Q, G, N)
    causal = jnp.tril(jnp.ones((Q, Q), dtype=bool))
    seg = a_cs[..., :, None] - a_cs[..., None, :]
    Ldec = jnp.exp(jnp.where(causal, seg, -jnp.inf))
    CB = jnp.einsum('bclgn,bcsgn->bcgls', Cc, Bc)
    y_diag = jnp.einsum('bcgkls,bcsgkp->bclgkp', CB[:, :, :, None] * Ldec, X)
    decay_states = jnp.exp(a_cs[..., -1:] - a_cs)
    states = jnp.einsum('bclgn,bcgkl,bclgkp->bcgkpn', Bc, decay_states, X)
    chunk_decay = jnp.exp(a_cs[..., -1])

    def step(carry, inp):
        st, dec = inp
        return carry * dec[..., None, None] + st, carry

    init = jnp.zeros((b, G, K, P, N), jnp.float32)
    _, prev = lax.scan(step, init, (jnp.moveaxis(states, 1, 0), jnp.moveaxis(chunk_decay, 1, 0)))
    prev = jnp.moveaxis(prev, 0, 1)
    y_off = jnp.einsum('bclgn,bcgkpn,bcgkl->bclgkp', Cc, prev, jnp.exp(a_cs))
    return (y_diag + y_off).reshape(b, s, H, P)


def ssd_branch(z, xbc, dt_raw, conv_w, conv_b, dt_bias, a_log, d_skip, norm_g):
    b, s, _ = z.shape
    f32 = jnp.float32
    xbc = jax.nn.silu(causal_dwconv(xbc, conv_w, conv_b))
    xs, Bm, Cm = jnp.split(xbc, (D_INNER, D_INNER + SSD_GROUPS * D_STATE), axis=-1)
    xs = xs.reshape(b, s, SSD_HEADS, SSD_HEAD_DIM).astype(f32)
    Bm = Bm.reshape(b, s, SSD_GROUPS, D_STATE).astype(f32)
    Cm = Cm.reshape(b, s, SSD_GROUPS, D_STATE).astype(f32)
    dt = jax.nn.softplus(dt_raw.astype(f32) + dt_bias.astype(f32))
    A = -jnp.exp(a_log.astype(f32))
    y = ssd_chunked(xs, dt, A, Bm, Cm) + d_skip.astype(f32)[:, None] * xs
    y = y.reshape(b, s, D_INNER) * jax.nn.silu(z.astype(f32))
    y = rms_norm(y.reshape(b, s, SSD_GROUPS, SSD_NORM_GROUP), norm_g.reshape(SSD_GROUPS, SSD_NORM_GROUP))
    return y.reshape(b, s, D_INNER).astype(z.dtype)


def dilated_window_attention(q, k, v, dil, n_back):
    b, s, h, hd = q.shape
    L = s // dil
    nb = -(-L // ATTN_BLOCK)
    Lp = nb * ATTN_BLOCK

    def to_sub(t):
        t = t.reshape(b, L, dil, h, hd).transpose(0, 2, 1, 3, 4).reshape(b * dil, L, h, hd)
        t = jnp.pad(t, ((0, 0), (0, Lp - L), (0, 0), (0, 0)))
        return t.reshape(b * dil, nb, ATTN_BLOCK, h, hd)

    def with_prev(t):
        prev = jnp.pad(t, ((0, 0), (1, 0), (0, 0), (0, 0), (0, 0)))[:, :-1]
        return jnp.concatenate([prev, t], axis=2)

    qb = to_sub(q)
    kc = with_prev(to_sub(k))
    vc = with_prev(to_sub(v))
    scores = jnp.einsum('znqhd,znkhd->znhqk', qb, kc) * (hd ** -0.5)
    qi = jnp.arange(ATTN_BLOCK)[:, None]
    ki = jnp.arange(2 * ATTN_BLOCK)[None, :]
    dist = ATTN_BLOCK + qi - ki
    band = (dist >= 0) & (dist <= n_back)
    key_pos = (jnp.arange(nb)[:, None, None] - 1) * ATTN_BLOCK + ki[None]
    mask = band[None] & (key_pos >= 0)
    scores = jnp.where(mask[None, :, None], scores, -jnp.inf)
    m = jnp.max(scores, axis=-1, keepdims=True)
    p = jnp.exp(scores - m)
    den = jnp.sum(p, axis=-1, keepdims=True)
    o = jnp.einsum('znhqk,znkhd->znqhd', p / den, vc)
    lse = (m + jnp.log(den))[..., 0]
    o = o.reshape(b, dil, Lp, h, hd)[:, :, :L].transpose(0, 2, 1, 3, 4).reshape(b, s, h, hd)
    lse = lse.transpose(0, 1, 3, 2).reshape(b, dil, Lp, h)[:, :, :L].transpose(0, 2, 1, 3).reshape(b, s, h)
    return o, lse


def attn_branch(q, k, v, q_norm_g, k_norm_g):
    b, s, _ = q.shape
    f32 = jnp.float32
    shp = (b, s, ATTN_N_GROUPS, ATTN_HEADS_PER_GROUP, ATTN_HEAD_DIM)
    qn = rms_norm(q.reshape(shp), q_norm_g).astype(f32)
    kn = rms_norm(k.reshape(shp), k_norm_g).astype(f32)
    vv = v.reshape(shp).astype(f32)
    outs, lses = [], []
    for gi in range(ATTN_N_GROUPS):
        o, lse = dilated_window_attention(qn[:, :, gi], kn[:, :, gi], vv[:, :, gi],
                                          ATTN_DILATIONS[gi], ATTN_WINDOWS[gi] // ATTN_DILATIONS[gi])
        outs.append(o)
        lses.append(lse)
    wts = jax.nn.softmax(jnp.stack(lses, axis=0), axis=0)
    o = jnp.einsum('gbsh,gbshd->bshd', wts, jnp.stack(outs, axis=0))
    return o.reshape(b, s, ATTN_OUT).astype(q.dtype)


def setup_inputs(seed: int = 0) -> dict:
    key = jax.random.key(seed)
    ks = jax.random.split(key, 20)
    f32 = jnp.float32

    def dense(k, shape, fan_in):
        return jax.random.normal(k, shape, f32) * fan_in ** -0.5

    def gain(k, shape):
        return 1.0 + 0.05 * jax.random.normal(k, shape, f32)

    x = jax.random.normal(ks[0], (BATCH, SEQ, D_MODEL), f32)
    norm1_g = gain(ks[1], (DEPTH, D_MODEL))
    w_in = dense(ks[2], (DEPTH, D_MODEL, D_IN_PROJ), D_MODEL)
    ssd_conv_w = dense(ks[3], (DEPTH, SSD_CONV, SSD_CONV_DIM), SSD_CONV)
    ssd_conv_b = 0.02 * jax.random.normal(ks[4], (DEPTH, SSD_CONV_DIM), f32)
    dt0 = jnp.exp(jax.random.uniform(ks[5], (DEPTH, SSD_HEADS), f32, math.log(1e-3), math.log(1e-1)))
    dt_bias = dt0 + jnp.log(-jnp.expm1(-dt0))
    a_log = jnp.log(jax.random.uniform(ks[6], (DEPTH, SSD_HEADS), f32, 1.0, 16.0))
    d_skip = 1.0 + 0.1 * jax.random.normal(ks[7], (DEPTH, SSD_HEADS), f32)
    ssd_norm_g = gain(ks[8], (DEPTH, D_INNER))
    w_ssd_proj = dense(ks[9], (DEPTH, D_INNER, D_MODEL), D_INNER)
    q_norm_g = gain(ks[10], (DEPTH, ATTN_HEAD_DIM))
    k_norm_g = gain(ks[11], (DEPTH, ATTN_HEAD_DIM))
    w_attn_proj = dense(ks[12], (DEPTH, ATTN_OUT, D_MODEL), ATTN_OUT)
    w_out = dense(ks[13], (DEPTH, D_MODEL, D_MODEL), D_MODEL)
    norm2_g = gain(ks[14], (DEPTH, D_MODEL))
    w_up = dense(ks[15], (DEPTH, D_MODEL, 2 * D_FF), D_MODEL)
    ffn_conv_w = dense(ks[16], (DEPTH, FFN_CONV, 2 * D_FF), FFN_CONV)
    ffn_conv_b = 0.02 * jax.random.normal(ks[17], (DEPTH, 2 * D_FF), f32)
    w_down = dense(ks[18], (DEPTH, D_FF, D_MODEL), D_FF)
    return {'x': x, 'norm1_g': norm1_g, 'w_in': w_in, 'ssd_conv_w': ssd_conv_w, 'ssd_conv_b': ssd_conv_b,
            'dt_bias': dt_bias, 'a_log': a_log, 'd_skip': d_skip, 'ssd_norm_g': ssd_norm_g,
            'w_ssd_proj': w_ssd_proj, 'q_norm_g': q_norm_g, 'k_norm_g': k_norm_g,
            'w_attn_proj': w_attn_proj, 'w_out': w_out, 'norm2_g': norm2_g, 'w_up': w_up,
            'ffn_conv_w': ffn_conv_w, 'ffn_conv_b': ffn_conv_b, 'w_down': w_down}


def reference(x, norm1_g, w_in, ssd_conv_w, ssd_conv_b, dt_bias, a_log, d_skip, ssd_norm_g,
              w_ssd_proj, q_norm_g, k_norm_g, w_attn_proj, w_out, norm2_g, w_up,
              ffn_conv_w, ffn_conv_b, w_down):
    for l in range(DEPTH):
        h = rms_norm(x, norm1_g[l])
        proj = h @ w_in[l]
        z, xbc, dt_raw, q, k, v, g_ssd, g_attn = jnp.split(proj, IN_SPLITS, axis=-1)
        y_ssd = ssd_branch(z, xbc, dt_raw, ssd_conv_w[l], ssd_conv_b[l], dt_bias[l], a_log[l],
                           d_skip[l], ssd_norm_g[l])
        y_attn = attn_branch(q, k, v, q_norm_g[l], k_norm_g[l])
        merged = (jax.nn.sigmoid(g_ssd) * (y_ssd @ w_ssd_proj[l])
                  + jax.nn.sigmoid(g_attn) * (y_attn @ w_attn_proj[l]))
        x = x + merged @ w_out[l]
        h2 = rms_norm(x, norm2_g[l])
        u = causal_dwconv(h2 @ w_up[l], ffn_conv_w[l], ffn_conv_b[l])
        u_gate, u_val = jnp.split(u, 2, axis=-1)
        x = x + (jax.nn.silu(u_gate) * u_val) @ w_down[l]
    return x
```

```cpp
#include <hip/hip_runtime.h>
#include <hip/hip_cooperative_groups.h>
#include <cstdio>
#include <cstdint>
namespace cg = cooperative_groups;

namespace pg8 {
#define PG8_LAS __attribute__((address_space(3)))
typedef unsigned short bf16_t;
typedef short bf16x8 __attribute__((ext_vector_type(8)));
typedef float f32x4 __attribute__((ext_vector_type(4)));
typedef float f32x16 __attribute__((ext_vector_type(16)));
typedef unsigned u32x4 __attribute__((ext_vector_type(4)));
typedef unsigned u32x2 __attribute__((ext_vector_type(2)));
constexpr int BM = 256, BK = 64, HALF = 128, HTB = HALF * BK * 2, STAGE_BYTES = 8 * HTB, NXCD = 8, WGM = 8;

__host__ __device__ __forceinline__ int lds_byte(int r, int c) { const int st = (r >> 4) * 2 + (c >> 5), rr = r & 15, cc = c & 31, ob = rr * 64 + cc * 2; return st * 1024 + (ob ^ (((ob >> 9) & 1) << 5)); }
__host__ __device__ __forceinline__ void stage_rc(int b, int& R, int& C) { const int st = b / 1024, sb = b % 1024, swz = sb ^ (((sb >> 9) & 1) << 5); R = (st >> 1) * 16 + swz / 64; C = (st & 1) * 32 + (swz % 64) / 2; }
__host__ __device__ __forceinline__ int perm32(int rho) { const int n = rho >> 4, i = rho & 15; return 8 * (i >> 2) + 4 * n + (i & 3); }

struct Unit { int pm, pn; };
struct Gemm { const bf16_t* A; const bf16_t* Bt; int M, N, K, lda; };

struct StaticOrder {
    int nM, nN, nwg, G, c;
    __host__ __device__ void init(int M, int N, int G_, int c_) { nM = M / BM; nN = N / BM; nwg = nM * nN; G = G_; c = c_; }
    __host__ __device__ bool next(int i, Unit& u) const {
        const long L = (long)i * G + c; if (L >= nwg) return false;
        int wgid = (int)L; { const int q = nwg / NXCD, r = nwg % NXCD, xcd = wgid % NXCD, off = wgid / NXCD; wgid = (xcd < r ? xcd * (q + 1) : r * (q + 1) + (xcd - r) * q) + off; }
        const int nig = WGM * nN, gid = wgid / nig, fm = gid * WGM, gsz = (nM - fm) < WGM ? (nM - fm) : WGM;
        u.pm = fm + ((wgid % nig) % gsz); u.pn = (wgid % nig) / gsz; return true;
    }
    __device__ __forceinline__ void a_ready(const Unit&) const {}
    __device__ __forceinline__ void done(const Unit&) const {}
};

__device__ __forceinline__ unsigned cvt_pk_bf16(float lo, float hi) { unsigned r; asm volatile("v_cvt_pk_bf16_f32 %0, %1, %2" : "=v"(r) : "v"(lo), "v"(hi)); return r; }

template <class Epi, class Sched>
__device__ __forceinline__ void gemm_phase(PG8_LAS unsigned char* lds, const Gemm g, const Sched& S, const Epi& E) {
    int tid_ = threadIdx.x; asm volatile("" : "+v"(tid_));
    const int tid = tid_, wid = __builtin_amdgcn_readfirstlane(tid >> 6), lane = tid & 63, wr = wid >> 2, wc = wid & 3, fr = lane & 15, fq = lane >> 4;
    const int K = g.K, nt = K / BK, lda = g.lda;
    unsigned voffA[2], voffB[2], voffB1[2];
#pragma unroll
    for (int i = 0; i < 2; ++i) { int R, C; stage_rc(tid * 16 + i * 8192, R, C); const int Rb = Epi::PERM ? ((R & ~31) + perm32(R & 31)) : R;
        voffA[i] = (unsigned)(R * lda + C) * 2u;
        if (Epi::ADJ) { const int r0 = 64 * (R >> 5) + perm32(R & 31); voffB[i] = (unsigned)(r0 * K + C) * 2u; voffB1[i] = (unsigned)((r0 + 32) * K + C) * 2u; }
        else { voffB[i] = (unsigned)(Rb * K + C) * 2u; voffB1[i] = voffB[i]; } }
    const size_t kstep = (size_t)(BK * 2);
    const size_t hstepA = (size_t)HALF * lda * 2, hstepBt = (size_t)HALF * K * 2, hstepB = Epi::ADJ ? (size_t)0 : hstepBt;
    const size_t tstepA = 2 * hstepA, tstepB = 2 * hstepBt;
    const unsigned ldsw = (unsigned)wid * 1024u;
    const int aoff = lds_byte(wr * 64 + fr, fq * 8), boff = lds_byte(wc * 32 + fr, fq * 8);
#define PG8_SA(b, h) (((b) * 2 + (h)) * HTB)
#define PG8_SB(b, h) ((4 + (b) * 2 + (h)) * HTB)
#define PG8_STAGE(bufoff, gbase, voff) do { _Pragma("unroll") for (int _i = 0; _i < 2; ++_i) \
        __builtin_amdgcn_global_load_lds((const unsigned*)((const char*)(gbase) + (voff)[_i]), (PG8_LAS unsigned*)(lds + (bufoff) + ldsw + _i * 8192), 16, 0, 0); } while (0)
#define PG8_LDA(dst, b, h) do { _Pragma("unroll") for (int m = 0; m < 4; ++m) _Pragma("unroll") for (int k = 0; k < 2; ++k) dst[m][k] = *(const PG8_LAS bf16x8*)(lds + PG8_SA(b, h) + aoff + m * 2048 + k * 1024); } while (0)
#define PG8_LDB(dst, b, h) do { _Pragma("unroll") for (int n = 0; n < 2; ++n) _Pragma("unroll") for (int k = 0; k < 2; ++k) dst[n][k] = *(const PG8_LAS bf16x8*)(lds + PG8_SB(b, h) + boff + n * 2048 + k * 1024); } while (0)
#define PG8_MMA(ai, bj, At, Bt) do { __builtin_amdgcn_s_setprio(1); _Pragma("unroll") for (int m = 0; m < 4; ++m) _Pragma("unroll") for (int n = 0; n < 2; ++n) _Pragma("unroll") for (int k = 0; k < 2; ++k) \
        acc[ai][bj][m][n] = __builtin_amdgcn_mfma_f32_16x16x32_bf16(Bt[n][k], At[m][k], acc[ai][bj][m][n], 0, 0, 0); __builtin_amdgcn_s_setprio(0); } while (0)
#define PG8_WAIT_V(n) asm volatile("s_waitcnt vmcnt(" #n ")" ::: "memory")
#define PG8_WAIT_L(n) asm volatile("s_waitcnt lgkmcnt(" #n ")" ::: "memory")
#define PG8_BAR __builtin_amdgcn_s_barrier()
#define PG8_SCHED __builtin_amdgcn_sched_barrier(0)
    Unit cur, nxt; int ui = 0;
    if (!S.next(0, cur)) return;
    f32x4 acc[2][2][4][2];
#pragma unroll
    for (int a = 0; a < 2; ++a)
#pragma unroll
        for (int b = 0; b < 2; ++b)
#pragma unroll
            for (int m = 0; m < 4; ++m)
#pragma unroll
                for (int n = 0; n < 2; ++n) acc[a][b][m][n] = (f32x4){0.f, 0.f, 0.f, 0.f};
    bf16x8 At[4][2], B0[2][2], B1[2][2];
    const char* cA = (const char*)g.A + (size_t)cur.pm * tstepA; const char* cB = (const char*)g.Bt + (size_t)cur.pn * tstepB;
    S.a_ready(cur);
    PG8_STAGE(PG8_SB(0, 0), cB, voffB); PG8_STAGE(PG8_SA(0, 0), cA, voffA); PG8_STAGE(PG8_SB(0, 1), cB + hstepB, voffB1); PG8_STAGE(PG8_SA(0, 1), cA + hstepA, voffA);
    if (wr == 1) PG8_BAR;
    PG8_WAIT_V(4); PG8_BAR;
    PG8_STAGE(PG8_SB(1, 0), cB + kstep, voffB); PG8_STAGE(PG8_SA(1, 0), cA + kstep, voffA); PG8_STAGE(PG8_SB(1, 1), cB + hstepB + kstep, voffB1);
    PG8_WAIT_V(6); PG8_BAR;
    for (;;) {
        const bool has_next = S.next(ui + 1, nxt);
        const char* nA = has_next ? (const char*)g.A + (size_t)nxt.pm * tstepA : cA; const char* nB = has_next ? (const char*)g.Bt + (size_t)nxt.pn * tstepB : cB;
        for (int t = 0; t < nt; t += 2) {
            const bool last = (t == nt - 2);
            const char* a1 = cA + (size_t)(t + 1) * kstep;
            const char* a2 = last ? nA : cA + (size_t)(t + 2) * kstep; const char* b2 = last ? nB : cB + (size_t)(t + 2) * kstep;
            const char* a3 = a2 + kstep; const char* b3 = b2 + kstep;
            if (last && has_next) S.a_ready(nxt);
            PG8_LDB(B0, 0, 0); PG8_SCHED; PG8_LDA(At, 0, 0); PG8_STAGE(PG8_SA(1, 1), a1 + hstepA, voffA);
            PG8_WAIT_L(8); PG8_BAR; PG8_WAIT_L(0); PG8_MMA(0, 0, At, B0); PG8_BAR; PG8_SCHED;
            PG8_LDB(B1, 0, 1); PG8_STAGE(PG8_SB(0, 0), b2, voffB);
            PG8_BAR; PG8_WAIT_L(0); PG8_MMA(0, 1, At, B1); PG8_BAR;
            PG8_LDA(At, 0, 1); PG8_STAGE(PG8_SA(0, 0), a2, voffA);
            PG8_BAR; PG8_WAIT_L(0); PG8_MMA(1, 0, At, B0); PG8_BAR; PG8_SCHED;
            PG8_STAGE(PG8_SB(0, 1), b2 + hstepB, voffB1);
            PG8_WAIT_V(6); PG8_BAR; PG8_MMA(1, 1, At, B1); PG8_BAR;
            PG8_LDB(B0, 1, 0); PG8_SCHED; PG8_LDA(At, 1, 0); PG8_STAGE(PG8_SA(0, 1), a2 + hstepA, voffA);
            PG8_WAIT_L(8); PG8_BAR; PG8_WAIT_L(0); PG8_MMA(0, 0, At, B0); PG8_BAR; PG8_SCHED;
            PG8_LDB(B1, 1, 1); PG8_STAGE(PG8_SB(1, 0), b3, voffB);
            PG8_BAR; PG8_WAIT_L(0); PG8_MMA(0, 1, At, B1); PG8_BAR;
            PG8_LDA(At, 1, 1); PG8_STAGE(PG8_SA(1, 0), a3, voffA);
            PG8_BAR; PG8_WAIT_L(0); PG8_MMA(1, 0, At, B0); PG8_BAR; PG8_SCHED;
            PG8_STAGE(PG8_SB(1, 1), b3 + hstepB, voffB1);
            PG8_WAIT_V(6); PG8_BAR; PG8_MMA(1, 1, At, B1); PG8_BAR;
        }
        E(acc, cur, wr, wc, fr, fq); S.done(cur);
        if (!has_next) break;
#pragma unroll
        for (int a = 0; a < 2; ++a)
#pragma unroll
            for (int b = 0; b < 2; ++b)
#pragma unroll
                for (int m = 0; m < 4; ++m)
#pragma unroll
                    for (int n = 0; n < 2; ++n) acc[a][b][m][n] = (f32x4){0.f, 0.f, 0.f, 0.f};
        cur = nxt; cA = nA; cB = nB; ++ui;
    }
    PG8_WAIT_V(0);
    if (wr == 0) PG8_BAR;
    PG8_BAR;
#undef PG8_SA
#undef PG8_SB
#undef PG8_STAGE
#undef PG8_LDA
#undef PG8_LDB
#undef PG8_MMA
#undef PG8_WAIT_V
#undef PG8_WAIT_L
#undef PG8_BAR
#undef PG8_SCHED
}
}

using pg8::bf16_t; using pg8::bf16x8; using pg8::f32x4; using pg8::f32x16; using pg8::u32x4; using pg8::u32x2; using pg8::Unit; using pg8::cvt_pk_bf16;
#define LAS __attribute__((address_space(3)))

constexpr int D_MODEL = 1024, SEQ = 4096, BATCH = 16;
constexpr int D_INNER = 2048, SSD_HEADS = 32, D_STATE = 128, CONV_DIM = 4096;
constexpr int D_FF = 2816;
constexpr int N_IN_SRC = 12832;
constexpr int N_IN_MAIN = 12800;
constexpr int N_IN_PAD = 13056;
constexpr int PLD = N_IN_MAIN;
constexpr int COL_Z = 0, COL_XBC = 2048, COL_Q = 6144, COL_GS = 10752, COL_GA = 11776;
constexpr float EPS = 1e-6f;
constexpr int LDS_BYTES = 147456;

constexpr size_t WS_BAR = 0;
constexpr size_t WS_BAR_BYTES = 16384;
constexpr size_t WS_WIN = WS_BAR_BYTES;
constexpr size_t WS_WSP = WS_WIN + (size_t)N_IN_PAD * 1024 * 2;
constexpr size_t WS_WAP = WS_WSP + (size_t)1024 * 2048 * 2;
constexpr size_t WS_WOUT = WS_WAP + (size_t)1024 * 512 * 2;
constexpr size_t WS_WUP = WS_WOUT + (size_t)1024 * 1024 * 2;
constexpr size_t WS_WDN = WS_WUP + (size_t)5632 * 1024 * 2;
constexpr size_t WS_ACT0 = WS_WDN + (size_t)1024 * 2816 * 2;
__host__ __device__ constexpr size_t ws_h(int T) { return WS_ACT0; }
__host__ __device__ constexpr size_t ws_dt(int T) { return ws_h(T) + (size_t)T * 2048; }
__host__ __device__ constexpr size_t ws_lse(int T) { return ws_dt(T) + (size_t)T * 128; }
__host__ __device__ constexpr size_t ws_proj(int T) { return ws_lse(T) + (size_t)T * 96; }
__host__ __device__ constexpr size_t ws_total(int T) { return ws_proj(T) + (size_t)T * 25600; }

struct Params {
    const float* x; const float* norm1_g; const float* w_in; const float* ssd_conv_w; const float* ssd_conv_b;
    const float* dt_bias; const float* a_log; const float* d_skip; const float* ssd_norm_g; const float* w_ssd_proj;
    const float* q_norm_g; const float* k_norm_g; const float* w_attn_proj; const float* w_out; const float* norm2_g;
    const float* w_up; const float* ffn_conv_w; const float* ffn_conv_b; const float* w_down;
    float* out; unsigned char* ws;
    int T, nchunks, ph_lo, ph_hi, pad0, pad1;
};

__device__ __forceinline__ float bf2f(unsigned short b) { return __uint_as_float(((unsigned)b) << 16); }
__device__ __forceinline__ float bflo(unsigned u) { return __uint_as_float(u << 16); }
__device__ __forceinline__ float bfhi(unsigned u) { return __uint_as_float(u & 0xffff0000u); }
__device__ __forceinline__ unsigned short f2bf(float f) { return (unsigned short)(cvt_pk_bf16(f, 0.f) & 0xffffu); }
__device__ __forceinline__ int otid() { int t = threadIdx.x; asm volatile("" : "+v"(t)); return t; }
__device__ __forceinline__ int obid() { int t = blockIdx.x; asm volatile("" : "+s"(t)); return t; }
__device__ __forceinline__ float sigmoidf_(float v) { return __builtin_amdgcn_rcpf(1.0f + __expf(-v)); }
__device__ __forceinline__ float siluf_(float v) { return v * __builtin_amdgcn_rcpf(1.0f + __expf(-v)); }
template <int CTRL> __device__ __forceinline__ float dppf(float old, float src) {
    return __builtin_bit_cast(float, __builtin_amdgcn_update_dpp(__builtin_bit_cast(int, old), __builtin_bit_cast(int, src), CTRL, 0xF, 0xF, false));
}

struct EpiInproj {
    static constexpr bool PERM = true, ADJ = true;
    bf16_t* O; float* dt;
    __device__ __forceinline__ void operator()(const f32x4 (&acc)[2][2][4][2], const Unit& u, int wr, int wc, int fr, int fq) const {
        const int row0 = u.pm * 256 + wr * 64 + fr;
        if (u.pn < 50) {
            const int col0 = u.pn * 256 + wc * 64 + 8 * fq;
#pragma unroll
            for (int ai = 0; ai < 2; ++ai)
#pragma unroll
                for (int m = 0; m < 4; ++m) { bf16_t* rowp = O + (size_t)(row0 + ai * 128 + m * 16) * PLD + col0;
#pragma unroll
                    for (int bj = 0; bj < 2; ++bj) { const f32x4 v0 = acc[ai][bj][m][0], v1 = acc[ai][bj][m][1];
                        u32x4 w; w.x = cvt_pk_bf16(v0[0], v0[1]); w.y = cvt_pk_bf16(v0[2], v0[3]); w.z = cvt_pk_bf16(v1[0], v1[1]); w.w = cvt_pk_bf16(v1[2], v1[3]);
                        *(u32x4*)(rowp + bj * 32) = w; } }
        } else if (wc == 0) {
#pragma unroll
            for (int ai = 0; ai < 2; ++ai)
#pragma unroll
                for (int m = 0; m < 4; ++m) { float* rp = dt + (size_t)(row0 + ai * 128 + m * 16) * 32 + 8 * fq;
                    *(f32x4*)(rp) = acc[ai][0][m][0]; *(f32x4*)(rp + 4) = acc[ai][0][m][1]; }
        }
    }
};
template <int MODE  > struct EpiGate {
    static constexpr bool PERM = true, ADJ = false;
    bf16_t* O; const bf16_t* G;
    __device__ __forceinline__ void operator()(const f32x4 (&acc)[2][2][4][2], const Unit& u, int wr, int wc, int fr, int fq) const {
        const int row0 = u.pm * 256 + wr * 64 + fr, col0 = u.pn * 256 + wc * 32 + 8 * fq;
#pragma unroll
        for (int ai = 0; ai < 2; ++ai) {
            u32x4 gq[4][2];
#pragma unroll
            for (int m = 0; m < 4; ++m)
#pragma unroll
                for (int bj = 0; bj < 2; ++bj) gq[m][bj] = *(const u32x4*)(G + (size_t)(row0 + ai * 128 + m * 16) * PLD + col0 + bj * 128);
#pragma unroll
            for (int mp = 0; mp < 2; ++mp) {
                u32x4 oq[2][2];
                if (MODE == 1) {
#pragma unroll
                    for (int mm = 0; mm < 2; ++mm)
#pragma unroll
                        for (int bj = 0; bj < 2; ++bj) oq[mm][bj] = *(const u32x4*)(O + (size_t)(row0 + ai * 128 + (mp * 2 + mm) * 16) * 1024 + col0 + bj * 128); }
#pragma unroll
                for (int mm = 0; mm < 2; ++mm)
#pragma unroll
                    for (int bj = 0; bj < 2; ++bj) { const int m = mp * 2 + mm; const size_t row = (size_t)(row0 + ai * 128 + m * 16);
                        const f32x4 v0 = acc[ai][bj][m][0], v1 = acc[ai][bj][m][1]; const u32x4 g4 = gq[m][bj];
                        float r[8];
                        r[0] = v0[0] * sigmoidf_(bflo(g4.x)); r[1] = v0[1] * sigmoidf_(bfhi(g4.x)); r[2] = v0[2] * sigmoidf_(bflo(g4.y)); r[3] = v0[3] * sigmoidf_(bfhi(g4.y));
                        r[4] = v1[0] * sigmoidf_(bflo(g4.z)); r[5] = v1[1] * sigmoidf_(bfhi(g4.z)); r[6] = v1[2] * sigmoidf_(bflo(g4.w)); r[7] = v1[3] * sigmoidf_(bfhi(g4.w));
                        if (MODE == 1) { const u32x4 o = oq[mm][bj];
                            r[0] += bflo(o.x); r[1] += bfhi(o.x); r[2] += bflo(o.y); r[3] += bfhi(o.y); r[4] += bflo(o.z); r[5] += bfhi(o.z); r[6] += bflo(o.w); r[7] += bfhi(o.w); }
                        u32x4 w; w.x = cvt_pk_bf16(r[0], r[1]); w.y = cvt_pk_bf16(r[2], r[3]); w.z = cvt_pk_bf16(r[4], r[5]); w.w = cvt_pk_bf16(r[6], r[7]);
                        *(u32x4*)(O + row * 1024 + col0 + bj * 128) = w; }
            }
        }
    }
};
struct EpiRes {
    static constexpr bool PERM = false, ADJ = false;
    float* dst; const float* src;
    __device__ __forceinline__ void operator()(const f32x4 (&acc)[2][2][4][2], const Unit& u, int wr, int wc, int fr, int fq) const {
        const int row0 = u.pm * 256 + wr * 64 + fr, col0 = u.pn * 256 + wc * 32 + 4 * fq;
#pragma unroll
        for (int ai = 0; ai < 2; ++ai)
#pragma unroll
            for (int mp = 0; mp < 2; ++mp) {
                f32x4 sv[2][2][2];
#pragma unroll
                for (int mm = 0; mm < 2; ++mm) { const size_t off = (size_t)(row0 + ai * 128 + (mp * 2 + mm) * 16) * 1024 + col0;
#pragma unroll
                    for (int bj = 0; bj < 2; ++bj)
#pragma unroll
                        for (int n = 0; n < 2; ++n) sv[mm][bj][n] = *(const f32x4*)(src + off + bj * 128 + n * 16); }
#pragma unroll
                for (int mm = 0; mm < 2; ++mm) { const int m = mp * 2 + mm; const size_t off = (size_t)(row0 + ai * 128 + m * 16) * 1024 + col0;
#pragma unroll
                    for (int bj = 0; bj < 2; ++bj)
#pragma unroll
                        for (int n = 0; n < 2; ++n) *(f32x4*)(dst + off + bj * 128 + n * 16) = sv[mm][bj][n] + acc[ai][bj][m][n]; }
            }
    }
};
struct EpiOut {
    static constexpr bool PERM = false, ADJ = false;
    float* dst; const float* src; bf16_t* xb; float* rowss;
    __device__ __forceinline__ void operator()(const f32x4 (&acc)[2][2][4][2], const Unit& u, int wr, int wc, int fr, int fq) const {
        const int row0 = u.pm * 256 + wr * 64 + fr, col0 = u.pn * 256 + wc * 32 + 4 * fq;
#pragma unroll
        for (int ai = 0; ai < 2; ++ai)
#pragma unroll
            for (int mp = 0; mp < 2; ++mp) {
                f32x4 sv[2][2][2];
#pragma unroll
                for (int mm = 0; mm < 2; ++mm) { const size_t off = (size_t)(row0 + ai * 128 + (mp * 2 + mm) * 16) * 1024 + col0;
#pragma unroll
                    for (int bj = 0; bj < 2; ++bj)
#pragma unroll
                        for (int n = 0; n < 2; ++n) sv[mm][bj][n] = *(const f32x4*)(src + off + bj * 128 + n * 16); }
#pragma unroll
                for (int mm = 0; mm < 2; ++mm) { const int m = mp * 2 + mm; const int row = row0 + ai * 128 + m * 16; const size_t off = (size_t)row * 1024 + col0; float ss = 0.f;
#pragma unroll
                    for (int bj = 0; bj < 2; ++bj)
#pragma unroll
                        for (int n = 0; n < 2; ++n) { const f32x4 v = sv[mm][bj][n] + acc[ai][bj][m][n];
                            ss += v[0] * v[0] + v[1] * v[1] + v[2] * v[2] + v[3] * v[3];
                            u32x2 o; o.x = cvt_pk_bf16(v[0], v[1]); o.y = cvt_pk_bf16(v[2], v[3]); *(u32x2*)(xb + off + bj * 128 + n * 16) = o; }
                    ss += __shfl_xor(ss, 16); ss += __shfl_xor(ss, 32);
                    if (fq == 0) atomicAdd(rowss + row, ss); }
            }
    }
};
struct EpiDown {
    static constexpr bool PERM = false, ADJ = false;
    float* dst; const bf16_t* xb;
    __device__ __forceinline__ void operator()(const f32x4 (&acc)[2][2][4][2], const Unit& u, int wr, int wc, int fr, int fq) const {
        const int row0 = u.pm * 256 + wr * 64 + fr, col0 = u.pn * 256 + wc * 32 + 4 * fq;
#pragma unroll
        for (int ai = 0; ai < 2; ++ai) {
            u32x2 sv[4][2][2];
#pragma unroll
            for (int m = 0; m < 4; ++m) { const size_t off = (size_t)(row0 + ai * 128 + m * 16) * 1024 + col0;
#pragma unroll
                for (int bj = 0; bj < 2; ++bj)
#pragma unroll
                    for (int n = 0; n < 2; ++n) sv[m][bj][n] = *(const u32x2*)(xb + off + bj * 128 + n * 16); }
#pragma unroll
            for (int m = 0; m < 4; ++m) { const size_t off = (size_t)(row0 + ai * 128 + m * 16) * 1024 + col0;
#pragma unroll
                for (int bj = 0; bj < 2; ++bj)
#pragma unroll
                    for (int n = 0; n < 2; ++n) { const u32x2 x2 = sv[m][bj][n]; const f32x4 a = acc[ai][bj][m][n];
                        f32x4 o; o[0] = bflo(x2.x) + a[0]; o[1] = bfhi(x2.x) + a[1]; o[2] = bflo(x2.y) + a[2]; o[3] = bfhi(x2.y) + a[3];
                        *(f32x4*)(dst + off + bj * 128 + n * 16) = o; } }
        }
    }
};
struct EpiUp {
    static constexpr bool PERM = true, ADJ = false;
    bf16_t* O; const float* rowss;
    __device__ __forceinline__ void operator()(const f32x4 (&acc)[2][2][4][2], const Unit& u, int wr, int wc, int fr, int fq) const {
        const int row0 = u.pm * 256 + wr * 64 + fr, col0 = u.pn * 256 + wc * 32 + 8 * fq;
        float rs[2][4];
#pragma unroll
        for (int ai = 0; ai < 2; ++ai)
#pragma unroll
            for (int m = 0; m < 4; ++m) rs[ai][m] = rowss[row0 + ai * 128 + m * 16];
#pragma unroll
        for (int ai = 0; ai < 2; ++ai)
#pragma unroll
            for (int m = 0; m < 4; ++m) { bf16_t* rowp = O + (size_t)(row0 + ai * 128 + m * 16) * 5632 + col0; const float r = rsqrtf(rs[ai][m] * (1.0f / 1024.0f) + EPS);
#pragma unroll
                for (int bj = 0; bj < 2; ++bj) { const f32x4 v0 = acc[ai][bj][m][0] * r, v1 = acc[ai][bj][m][1] * r;
                    u32x4 w; w.x = cvt_pk_bf16(v0[0], v0[1]); w.y = cvt_pk_bf16(v0[2], v0[3]); w.z = cvt_pk_bf16(v1[0], v1[1]); w.w = cvt_pk_bf16(v1[2], v1[3]);
                    *(u32x4*)(rowp + bj * 128) = w; } }
    }
};
struct EpiUpConv {
    static constexpr bool PERM = true, ADJ = false;
    bf16_t* act; bf16_t* side; const float* rowss; const float* cw; const float* cbias;
    struct W8 { f32x4 wg[3], wv[3], bg, bv; };
    __device__ __forceinline__ void loadw(W8& w, int c) const {
#pragma unroll
        for (int i = 0; i < 3; ++i) { w.wg[i] = *(const f32x4*)(cw + i * 5632 + c); w.wv[i] = *(const f32x4*)(cw + i * 5632 + D_FF + c); }
        w.bg = *(const f32x4*)(cbias + c); w.bv = *(const f32x4*)(cbias + D_FF + c);
    }
    template <int N> __device__ __forceinline__ void half(const f32x4 (&acc)[2][2][4][2], const W8& w, const float (&rs)[2][4], int ai, const Unit& u, int wr, int wc, int fr, int fq) const {
        const int row0 = u.pm * 256 + wr * 64 + fr; const int cu = u.pn * 128 + wc * 32 + 8 * fq + 4 * N; const int nd0 = u.pn * 256 + wc * 32 + 8 * fq + 4 * N;
        const int slab = u.pm * 4 + ai * 2 + wr;
        f32x4 pg = (f32x4){0.f, 0.f, 0.f, 0.f}, pv = pg;
#pragma unroll
        for (int m = 0; m < 4; ++m) {
            const float r = rsqrtf(rs[ai][m] * (1.0f / 1024.0f) + EPS);
            const f32x4 ug = acc[ai][0][m][N] * r, uv = acc[ai][1][m][N] * r;
            float o[4];
#pragma unroll
            for (int e = 0; e < 4; ++e) {
                const float g1 = dppf<0x111>(dppf<0x121>(pg[e], pg[e]), ug[e]), g2 = dppf<0x112>(dppf<0x122>(pg[e], pg[e]), ug[e]);
                const float v1 = dppf<0x111>(dppf<0x121>(pv[e], pv[e]), uv[e]), v2 = dppf<0x112>(dppf<0x122>(pv[e], pv[e]), uv[e]);
                const float cg = w.bg[e] + w.wg[0][e] * g2 + w.wg[1][e] * g1 + w.wg[2][e] * ug[e];
                const float cv = w.bv[e] + w.wv[0][e] * v2 + w.wv[1][e] * v1 + w.wv[2][e] * uv[e];
                o[e] = siluf_(cg) * cv; }
            const size_t row = (size_t)(row0 + ai * 128 + m * 16);
            if (m > 0 || fr >= 2) { u32x2 ow; ow.x = cvt_pk_bf16(o[0], o[1]); ow.y = cvt_pk_bf16(o[2], o[3]); *(u32x2*)(act + row * D_FF + cu) = ow; }
            if ((m == 0 && fr < 2) || (m == 3 && fr >= 14)) { const int which = m == 0 ? fr : fr - 12;
                bf16_t* sp = side + ((size_t)slab * 4 + which) * 5632 + nd0;
                u32x2 a; a.x = cvt_pk_bf16(ug[0], ug[1]); a.y = cvt_pk_bf16(ug[2], ug[3]); *(u32x2*)sp = a;
                u32x2 b; b.x = cvt_pk_bf16(uv[0], uv[1]); b.y = cvt_pk_bf16(uv[2], uv[3]); *(u32x2*)(sp + 128) = b; }
            pg = ug; pv = uv;
        }
    }
    __device__ __forceinline__ void operator()(const f32x4 (&acc)[2][2][4][2], const Unit& u, int wr, int wc, int fr, int fq) const {
        const int row0 = u.pm * 256 + wr * 64 + fr; const int cu = u.pn * 128 + wc * 32 + 8 * fq;
        W8 w0, w1; loadw(w0, cu);
        float rs[2][4];
#pragma unroll
        for (int ai = 0; ai < 2; ++ai)
#pragma unroll
            for (int m = 0; m < 4; ++m) rs[ai][m] = rowss[row0 + ai * 128 + m * 16];
        half<0>(acc, w0, rs, 0, u, wr, wc, fr, fq);
        loadw(w1, cu + 4);
        half<0>(acc, w0, rs, 1, u, wr, wc, fr, fq);
        half<1>(acc, w1, rs, 0, u, wr, wc, fr, fq);
        half<1>(acc, w1, rs, 1, u, wr, wc, fr, fq);
    }
};
struct EpiBf16 {
    static constexpr bool PERM = true, ADJ = false;
    bf16_t* O; int ldc;
    __device__ __forceinline__ void operator()(const f32x4 (&acc)[2][2][4][2], const Unit& u, int wr, int wc, int fr, int fq) const {
        const int row0 = u.pm * 256 + wr * 64 + fr, col0 = u.pn * 256 + wc * 32 + 8 * fq;
#pragma unroll
        for (int ai = 0; ai < 2; ++ai)
#pragma unroll
            for (int m = 0; m < 4; ++m) { bf16_t* rowp = O + (size_t)(row0 + ai * 128 + m * 16) * ldc + col0;
#pragma unroll
                for (int bj = 0; bj < 2; ++bj) { const f32x4 v0 = acc[ai][bj][m][0], v1 = acc[ai][bj][m][1];
                    u32x4 w; w.x = cvt_pk_bf16(v0[0], v0[1]); w.y = cvt_pk_bf16(v0[2], v0[3]); w.z = cvt_pk_bf16(v1[0], v1[1]); w.w = cvt_pk_bf16(v1[2], v1[3]);
                    *(u32x4*)(rowp + bj * 128) = w; } }
    }
};
template <class Epi> __device__ __forceinline__ void run_gemm(LAS unsigned char* lds, const bf16_t* A, int lda, const bf16_t* Bt, int M, int N, int K, const Epi& E) {
    pg8::Gemm g; g.A = A; g.Bt = Bt; g.M = M; g.N = N; g.K = K; g.lda = lda;
    pg8::StaticOrder S; S.init(M, N, (int)gridDim.x, obid());
    pg8::gemm_phase<Epi, pg8::StaticOrder>(lds, g, S, E);
}

__device__ __forceinline__ void wprep_tile(const float* __restrict__ src, int Nsrc, int K, bf16_t* __restrict__ dst, int tn, int tk, int mode, LAS float* tl, const float* __restrict__ kscale = nullptr) {
    const int tid = otid(); const int nd0 = tn * 64, k0 = tk * 64;
    { const int nn = tid & 63; const int nd = nd0 + nn; int ns = nd;
      if (mode == 1) { if (nd < 6144) ns = nd; else if (nd < N_IN_MAIN) ns = nd + 32; else if (nd < N_IN_MAIN + 32) ns = 6144 + (nd - N_IN_MAIN); else ns = -1; }
      if (mode == 2) { const int tile = nd >> 8, within = nd & 255; ns = within < 128 ? tile * 128 + within : D_FF + tile * 128 + (within - 128); }
#pragma unroll
      for (int it = 0; it < 8; ++it) { const int kk = it * 8 + (tid >> 6); tl[kk * 65 + nn] = ns >= 0 ? src[(size_t)(k0 + kk) * Nsrc + ns] : 0.f; } }
    __syncthreads();
    { const int kk = tid & 63; const float ksc = kscale ? kscale[k0 + kk] : 1.0f;
#pragma unroll
      for (int it = 0; it < 8; ++it) { const int nn = it * 8 + (tid >> 6); dst[(size_t)(nd0 + nn) * K + k0 + kk] = f2bf(tl[kk * 65 + nn] * ksc); } }
    __syncthreads();
}
__device__ __forceinline__ void phase_wprep(const Params& p, LAS unsigned char* lds) {
    LAS float* tl = (LAS float*)lds;
    constexpr int n0 = 204 * 16, n1 = n0 + 16 * 32, n2 = n1 + 16 * 8, n3 = n2 + 16 * 16, n4 = n3 + 88 * 16, n5 = n4 + 16 * 44;
    for (int t = obid(); t < n5; t += gridDim.x) {
        if (t < n0) wprep_tile(p.w_in, N_IN_SRC, 1024, (bf16_t*)(p.ws + WS_WIN), t / 16, t % 16, 1, tl);
        else if (t < n1) { const int q = t - n0; wprep_tile(p.w_ssd_proj, 1024, 2048, (bf16_t*)(p.ws + WS_WSP), q / 32, q % 32, 0, tl); }
        else if (t < n2) { const int q = t - n1; wprep_tile(p.w_attn_proj, 1024, 512, (bf16_t*)(p.ws + WS_WAP), q / 8, q % 8, 0, tl); }
        else if (t < n3) { const int q = t - n2; wprep_tile(p.w_out, 1024, 1024, (bf16_t*)(p.ws + WS_WOUT), q / 16, q % 16, 0, tl); }
        else if (t < n4) { const int q = t - n3; wprep_tile(p.w_up, 5632, 1024, (bf16_t*)(p.ws + WS_WUP), q / 16, q % 16, 2, tl, p.norm2_g); }
        else { const int q = t - n4; wprep_tile(p.w_down, 1024, 2816, (bf16_t*)(p.ws + WS_WDN), q / 44, q % 44, 0, tl); }
    }
}

__device__ __forceinline__ void phase_rms(const float* __restrict__ src, const float* __restrict__ g, bf16_t* __restrict__ dst, int T) {
    const int tid = otid(), w = tid >> 6, lane = tid & 63;
    f32x4 gv[4];
#pragma unroll
    for (int i = 0; i < 4; ++i) gv[i] = *(const f32x4*)(g + i * 256 + lane * 4);
    for (int row = obid() * 8 + w; row < T; row += gridDim.x * 8) {
        const float* rp = src + (size_t)row * 1024;
        f32x4 v[4]; float ss = 0.f;
#pragma unroll
        for (int i = 0; i < 4; ++i) { v[i] = *(const f32x4*)(rp + i * 256 + lane * 4); ss += v[i][0] * v[i][0] + v[i][1] * v[i][1] + v[i][2] * v[i][2] + v[i][3] * v[i][3]; }
#pragma unroll
        for (int o = 32; o >= 1; o >>= 1) ss += __shfl_xor(ss, o);
        const float rs = rsqrtf(ss * (1.0f / 1024.0f) + EPS);
        bf16_t* op = dst + (size_t)row * 1024;
#pragma unroll
        for (int i = 0; i < 4; ++i) { u32x2 o; o.x = cvt_pk_bf16(v[i][0] * rs * gv[i][0], v[i][1] * rs * gv[i][1]); o.y = cvt_pk_bf16(v[i][2] * rs * gv[i][2], v[i][3] * rs * gv[i][3]);
            *(u32x2*)(op + i * 256 + lane * 4) = o; }
    }
}

constexpr int SLD = 136;
constexpr int L_CM = 0, L_BM = 34816, L_BT = 69632, L_XT = 104448, L_SB = 121856, L_FA = 139264;
__device__ __forceinline__ f32x16 mma32_k(const LAS bf16_t* A, const LAS bf16_t* B, int ksteps, f32x16 acc, int lane) {
    const LAS bf16_t* ap = A + (lane & 31) * SLD + (lane >> 5) * 8; const LAS bf16_t* bp = B + (lane & 31) * SLD + (lane >> 5) * 8;
    for (int ks = 0; ks < ksteps; ks += 2) {
        const bf16x8 a0 = *(const LAS bf16x8*)(ap + ks * 16), a1 = *(const LAS bf16x8*)(ap + ks * 16 + 16);
        const bf16x8 b0 = *(const LAS bf16x8*)(bp + ks * 16), b1 = *(const LAS bf16x8*)(bp + ks * 16 + 16);
        acc = __builtin_amdgcn_mfma_f32_32x32x16_bf16(a0, b0, acc, 0, 0, 0);
        acc = __builtin_amdgcn_mfma_f32_32x32x16_bf16(a1, b1, acc, 0, 0, 0); }
    return acc;
}
__device__ __forceinline__ f32x16 mma32_k8(const LAS bf16_t* A, const LAS bf16_t* B, f32x16 acc, int lane) {
    const LAS bf16_t* ap = A + (lane & 31) * SLD + (lane >> 5) * 8; const LAS bf16_t* bp = B + (lane & 31) * SLD + (lane >> 5) * 8;
#pragma unroll
    for (int h = 0; h < 2; ++h) {
        bf16x8 a[4], b[4];
#pragma unroll
        for (int ks = 0; ks < 4; ++ks) { a[ks] = *(const LAS bf16x8*)(ap + (h * 4 + ks) * 16); b[ks] = *(const LAS bf16x8*)(bp + (h * 4 + ks) * 16); }
#pragma unroll
        for (int ks = 0; ks < 4; ++ks) acc = __builtin_amdgcn_mfma_f32_32x32x16_bf16(a[ks], b[ks], acc, 0, 0, 0);
    }
    return acc;
}
__device__ __forceinline__ void ssd_item(const Params& p, LAS unsigned char* lds, int bl, int head, int dry) {
    const int tid = otid(), w = tid >> 6, lane = tid & 63; const int T = p.T;
    bf16_t* proj = (bf16_t*)(p.ws + ws_proj(T)); const float* dtraw = (const float*)(p.ws + ws_dt(T));
    LAS bf16_t* CM = (LAS bf16_t*)(lds + L_CM); LAS bf16_t* BMm = (LAS bf16_t*)(lds + L_BM); LAS bf16_t* BT = (LAS bf16_t*)(lds + L_BT);
    LAS bf16_t* XT = (LAS bf16_t*)(lds + L_XT); LAS bf16_t* SB = (LAS bf16_t*)(lds + L_SB);
    LAS float* fs = (LAS float*)(lds + L_FA);
    const float Ah = -__expf(p.a_log[head]), Dh = p.d_skip[head], dtb = p.dt_bias[head];
    const int g = head >> 2; const size_t rowbase = (size_t)bl * SEQ;
    const int pt = w >> 2, nt = w & 3;
    const int rsub = 4 * (lane >> 5), cl = lane & 31;
    const bool cact = tid < 320; const int cq = tid % 80, rg = (tid / 80) & 3, rgc = tid < 320 ? tid / 80 : 3;
    int kind, n4, col, ch;
    if (cq < 16) { kind = 0; n4 = 4 * cq; col = COL_XBC + head * 64 + n4; ch = head * 64 + n4; }
    else if (cq < 48) { kind = 1; n4 = 4 * (cq - 16); col = COL_XBC + 2048 + g * 128 + n4; ch = 2048 + g * 128 + n4; }
    else { kind = 2; n4 = 4 * (cq - 48); col = COL_XBC + 3072 + g * 128 + n4; ch = 3072 + g * 128 + n4; }
    f32x4 cw0, cw1, cw2, cw3, cbv;
    cw0 = *(const f32x4*)(p.ssd_conv_w + ch); cw1 = *(const f32x4*)(p.ssd_conv_w + CONV_DIM + ch); cw2 = *(const f32x4*)(p.ssd_conv_w + 2 * CONV_DIM + ch); cw3 = *(const f32x4*)(p.ssd_conv_w + 3 * CONV_DIM + ch);
    cbv = *(const f32x4*)(p.ssd_conv_b + ch);
    u32x2 raw[35]; float dtn0 = 0.f, dtn1 = 0.f; u32x2 zr[4];
    const size_t pstep = cact ? (size_t)PLD : (size_t)0;
    const int ti_d = w >> 1, pc_d = w & 1;
#define SSD_ISSUE(c_) do { const int c__ = (c_); \
        { const float* dp = dtraw + (rowbase + (size_t)c__ * 128 + lane) * 32 + head; dtn0 = dp[0]; dtn1 = dp[64 * 32]; } \
        { const int sb__ = cact ? c__ * 128 + rgc * 32 - 3 : 0; const bf16_t* gp = proj + rowbase * PLD + (cact ? col : COL_XBC); \
            _Pragma("unroll") for (int i = 0; i < 3; ++i) { const int sq = sb__ + i; raw[i] = *(const u32x2*)(gp + (size_t)(sq < 0 ? 0 : sq) * PLD); } \
            const bf16_t* gp3 = gp + (size_t)(sb__ + 3) * PLD; \
            _Pragma("unroll") for (int i = 3; i < 35; ++i) raw[i] = *(const u32x2*)(gp3 + (size_t)(i - 3) * pstep); } } while (0)
#define SSD_SCAN(c_) do { const int par__ = (c_) & 1; LAS float* f__ = fs + par__ * 384; \
        float v0 = dtn0 + dtb, v1 = dtn1 + dtb; const float d0 = v0 > 20.f ? v0 : log1pf(__expf(v0)), d1 = v1 > 20.f ? v1 : log1pf(__expf(v1)); \
        float s0 = d0 * Ah, s1 = d1 * Ah; \
        _Pragma("unroll") for (int o = 1; o < 64; o <<= 1) { const float t0 = __shfl_up(s0, o), t1 = __shfl_up(s1, o); if (lane >= o) { s0 += t0; s1 += t1; } } \
        s1 += __shfl(s0, 63); const float cl__ = __shfl(s1, 63); \
        f__[lane] = s0; f__[64 + lane] = s1; f__[128 + lane] = d0; f__[192 + lane] = d1; f__[256 + lane] = __expf(cl__ - s0); f__[320 + lane] = __expf(cl__ - s1); } while (0)
    SSD_ISSUE(0);
    if (w == 0) SSD_SCAN(0);
    f32x16 accS;
#pragma unroll
    for (int i = 0; i < 16; ++i) accS[i] = 0.f;
    for (int c = 0; c < 32; ++c) {
        const size_t r0 = rowbase + (size_t)c * 128;
        LAS float* fcs = fs + (c & 1) * 384; LAS float* fdt = fcs + 128; LAS float* fwl = fcs + 256;
        __syncthreads();
#pragma unroll
        for (int r = 0; r < 16; ++r) { const int row = (r & 3) + 8 * (r >> 2) + rsub; SB[(pt * 32 + row) * SLD + nt * 32 + cl] = f2bf(accS[r]); }
        if (cact) {
            if (c == 0 && rg == 0) { raw[0] = (u32x2){0u, 0u}; raw[1] = (u32x2){0u, 0u}; raw[2] = (u32x2){0u, 0u}; }
#pragma unroll
            for (int seg = 0; seg < 4; ++seg) {
                float val[8][4];
#pragma unroll
                for (int j = 0; j < 8; ++j) { const int i = seg * 8 + j;
                    const u32x2 x0 = raw[i], x1 = raw[i + 1], x2 = raw[i + 2], x3 = raw[i + 3];
                    float v0 = cbv[0] + cw0[0] * bflo(x0.x) + cw1[0] * bflo(x1.x) + cw2[0] * bflo(x2.x) + cw3[0] * bflo(x3.x);
                    float v1 = cbv[1] + cw0[1] * bfhi(x0.x) + cw1[1] * bfhi(x1.x) + cw2[1] * bfhi(x2.x) + cw3[1] * bfhi(x3.x);
                    float v2 = cbv[2] + cw0[2] * bflo(x0.y) + cw1[2] * bflo(x1.y) + cw2[2] * bflo(x2.y) + cw3[2] * bflo(x3.y);
                    float v3 = cbv[3] + cw0[3] * bfhi(x0.y) + cw1[3] * bfhi(x1.y) + cw2[3] * bfhi(x2.y) + cw3[3] * bfhi(x3.y);
                    val[j][0] = siluf_(v0); val[j][1] = siluf_(v1); val[j][2] = siluf_(v2); val[j][3] = siluf_(v3); }
                const int lb = rg * 32 + seg * 8;
                if (kind != 0) { LAS bf16_t* rm = (kind == 1 ? BMm : CM) + lb * SLD + n4;
#pragma unroll
                    for (int j = 0; j < 8; ++j) { u32x2 o; o.x = cvt_pk_bf16(val[j][0], val[j][1]); o.y = cvt_pk_bf16(val[j][2], val[j][3]); *(LAS u32x2*)(rm + j * SLD) = o; } }
                if (kind != 2) { LAS float* sc = (kind == 0 ? fdt : fwl) + lb; LAS bf16_t* tp = (kind == 0 ? XT : BT) + n4 * SLD + lb;
                    float scl[8];
#pragma unroll
                    for (int j = 0; j < 8; ++j) scl[j] = sc[j];
#pragma unroll
                    for (int e = 0; e < 4; ++e) { u32x4 o; o.x = cvt_pk_bf16(val[0][e] * scl[0], val[1][e] * scl[1]); o.y = cvt_pk_bf16(val[2][e] * scl[2], val[3][e] * scl[3]);
                        o.z = cvt_pk_bf16(val[4][e] * scl[4], val[5][e] * scl[5]); o.w = cvt_pk_bf16(val[6][e] * scl[6], val[7][e] * scl[7]); *(LAS u32x4*)(tp + e * SLD) = o; } }
            }
        }
        { const bf16_t* zp = proj + (r0 + ti_d * 32 + cl) * PLD + COL_Z + head * 64 + pc_d * 32 + rsub;
#pragma unroll
          for (int g4 = 0; g4 < 4; ++g4) zr[g4] = *(const u32x2*)(zp + 8 * g4); }
        __builtin_amdgcn_sched_barrier(0);
        SSD_ISSUE(c + 1 < 32 ? c + 1 : 31);
        __syncthreads();
        f32x16 cb[2]; int ti[2], tj[2];
#pragma unroll
        for (int q = 0; q < 2; ++q) { const int id = w + 8 * q; ti[q] = id >> 2; tj[q] = id & 3;
#pragma unroll
            for (int i = 0; i < 16; ++i) cb[q][i] = 0.f;
            if (tj[q] <= ti[q]) cb[q] = mma32_k8(CM + ti[q] * 32 * SLD, BMm + tj[q] * 32 * SLD, cb[q], lane); }
        __syncthreads();
#pragma unroll
        for (int q = 0; q < 2; ++q) if (tj[q] <= ti[q]) {
            const int s = tj[q] * 32 + cl; const float css = fcs[s];
#pragma unroll
            for (int r = 0; r < 16; ++r) { const int l = ti[q] * 32 + (r & 3) + 8 * (r >> 2) + rsub;
                const float mv = (s <= l) ? cb[q][r] * __expf(fcs[l] - css) : 0.f; BMm[l * SLD + s] = f2bf(mv); } }
        if (w == 0 && c + 1 < 32) SSD_SCAN(c + 1);
        __syncthreads();
        { const int i = ti_d, pc = pc_d;
          f32x16 accd, acco;
#pragma unroll
          for (int r = 0; r < 16; ++r) { accd[r] = 0.f; acco[r] = 0.f; }
          accd = mma32_k(XT + pc * 32 * SLD, BMm + i * 32 * SLD, 2 * (i + 1), accd, lane);
          acco = mma32_k8(SB + pc * 32 * SLD, CM + i * 32 * SLD, acco, lane);
          const int l = i * 32 + cl; const float ecs = __expf(fcs[l]), dsc = Dh * __builtin_amdgcn_rcpf(fdt[l]);
          bf16_t* zp = proj + (r0 + l) * PLD + COL_Z + head * 64 + pc * 32 + rsub;
#pragma unroll
          for (int g4 = 0; g4 < 4; ++g4) { float y[4];
#pragma unroll
              for (int e = 0; e < 4; ++e) { const int pp = pc * 32 + 8 * g4 + rsub + e; y[e] = accd[g4 * 4 + e] + ecs * acco[g4 * 4 + e] + dsc * bf2f(XT[pp * SLD + l]); }
              const u32x2 z2 = zr[g4];
              y[0] *= siluf_(bflo(z2.x)); y[1] *= siluf_(bfhi(z2.x)); y[2] *= siluf_(bflo(z2.y)); y[3] *= siluf_(bfhi(z2.y));
              u32x2 o; o.x = cvt_pk_bf16(y[0], y[1]); o.y = cvt_pk_bf16(y[2], y[3]);
              if (!dry) *(u32x2*)(zp + 8 * g4) = o; } }
        { const float cd = __expf(fcs[127]);
#pragma unroll
          for (int r = 0; r < 16; ++r) accS[r] *= cd;
          accS = mma32_k8(XT + pt * 32 * SLD, BT + nt * 32 * SLD, accS, lane); }
    }
    __syncthreads();
#undef SSD_ISSUE
#undef SSD_SCAN
}

constexpr int KLD = 72, VLD = 392; constexpr int L_KS = 0, L_VT = 384 * KLD * 2;
struct AttnItem { size_t rowbase; int gi, h, r, nbk0, d, qcol; };
__device__ __forceinline__ AttnItem attn_decode(int a) {
    AttnItem I; I.h = a & 7; const int j = (a & 127) >> 3; const int gb = a >> 7; const int bl = gb / 3; I.gi = gb - bl * 3;
    const int lg = I.gi * 2; I.d = 1 << lg; I.r = j & (I.d - 1); I.nbk0 = (j >> lg) * 2; I.rowbase = (size_t)bl * SEQ; I.qcol = COL_Q + I.gi * 512 + I.h * 64; return I;
}
__device__ __forceinline__ void attn_load(const bf16_t* proj, const AttnItem& I, int tid, u32x4 (&kr)[6], u32x4 (&vr)[6], u32x4 (&qr)[2][2]) {
    const int piece = tid & 7, w = tid >> 6, lane = tid & 63;
#pragma unroll
    for (int it = 0; it < 6; ++it) { const int kk = it * 64 + (tid >> 3); const int km = I.nbk0 * 128 - 128 + kk;
        const size_t tok = I.rowbase + (size_t)(km < 0 ? 0 : km) * I.d + I.r;
        const u32x4 k4 = *(const u32x4*)(proj + tok * PLD + I.qcol + 1536 + piece * 8), v4 = *(const u32x4*)(proj + tok * PLD + I.qcol + 3072 + piece * 8);
        kr[it].x = km < 0 ? 0u : k4.x; kr[it].y = km < 0 ? 0u : k4.y; kr[it].z = km < 0 ? 0u : k4.z; kr[it].w = km < 0 ? 0u : k4.w;
        vr[it].x = km < 0 ? 0u : v4.x; vr[it].y = km < 0 ? 0u : v4.y; vr[it].z = km < 0 ? 0u : v4.z; vr[it].w = km < 0 ? 0u : v4.w; }
#pragma unroll
    for (int blk = 0; blk < 2; ++blk) { const int qq = 16 * w + (lane & 15); const size_t tokq = I.rowbase + (size_t)((I.nbk0 + blk) * 128 + qq) * I.d + I.r;
        qr[blk][0] = *(const u32x4*)(proj + tokq * PLD + I.qcol + 8 * (lane >> 4)); qr[blk][1] = *(const u32x4*)(proj + tokq * PLD + I.qcol + 32 + 8 * (lane >> 4)); }
}
__device__ __forceinline__ void attn_item(const Params& p, LAS unsigned char* lds, const AttnItem& I, const AttnItem& N, u32x4 (&kr)[6], u32x4 (&vr)[6], u32x4 (&qr)[2][2],
                                          const float (&gk)[8], const float (&gq)[2][8], int dry) {
    const int tid = otid(), w = tid >> 6, lane = tid & 63; const int T = p.T;
    bf16_t* proj = (bf16_t*)(p.ws + ws_proj(T)); float* lse = (float*)(p.ws + ws_lse(T));
    LAS bf16_t* KS = (LAS bf16_t*)(lds + L_KS); LAS bf16_t* VT = (LAS bf16_t*)(lds + L_VT);
    const int gi = I.gi, h = I.h, d = I.d, r = I.r; const size_t rowbase = I.rowbase; const int qcol = I.qcol;
    __syncthreads();
    { const int piece = tid & 7;
#pragma unroll
      for (int it = 0; it < 6; ++it) { const int kk = it * 64 + (tid >> 3);
          const u32x4 k4 = kr[it], v4 = vr[it];
          float kf[8]; kf[0] = bflo(k4.x); kf[1] = bfhi(k4.x); kf[2] = bflo(k4.y); kf[3] = bfhi(k4.y); kf[4] = bflo(k4.z); kf[5] = bfhi(k4.z); kf[6] = bflo(k4.w); kf[7] = bfhi(k4.w);
          float ss = 0.f;
#pragma unroll
          for (int e = 0; e < 8; ++e) ss += kf[e] * kf[e];
          ss += dppf<0xB1>(ss, ss); ss += dppf<0x4E>(ss, ss); ss += dppf<0x141>(ss, ss);
          const float rs = rsqrtf(ss * (1.0f / 64.0f) + EPS);
          u32x4 ko; ko.x = cvt_pk_bf16(kf[0] * rs * gk[0], kf[1] * rs * gk[1]); ko.y = cvt_pk_bf16(kf[2] * rs * gk[2], kf[3] * rs * gk[3]);
          ko.z = cvt_pk_bf16(kf[4] * rs * gk[4], kf[5] * rs * gk[5]); ko.w = cvt_pk_bf16(kf[6] * rs * gk[6], kf[7] * rs * gk[7]);
          *(LAS u32x4*)(KS + kk * KLD + piece * 8) = ko;
          LAS bf16_t* vp = VT + (piece * 8) * VLD + kk;
          vp[0] = (bf16_t)(v4.x & 0xffffu); vp[VLD] = (bf16_t)(v4.x >> 16); vp[2 * VLD] = (bf16_t)(v4.y & 0xffffu); vp[3 * VLD] = (bf16_t)(v4.y >> 16);
          vp[4 * VLD] = (bf16_t)(v4.z & 0xffffu); vp[5 * VLD] = (bf16_t)(v4.z >> 16); vp[6 * VLD] = (bf16_t)(v4.w & 0xffffu); vp[7 * VLD] = (bf16_t)(v4.w >> 16); } }
    const int fr = lane & 15, fq = lane >> 4;
    const int qq = 16 * w + fr;
    bf16x8 qf[2][2];
#pragma unroll
    for (int blk = 0; blk < 2; ++blk) { float qv[2][8]; float ss = 0.f;
#pragma unroll
      for (int ks = 0; ks < 2; ++ks) { const u32x4 q4 = qr[blk][ks]; qv[ks][0] = bflo(q4.x); qv[ks][1] = bfhi(q4.x); qv[ks][2] = bflo(q4.y); qv[ks][3] = bfhi(q4.y);
          qv[ks][4] = bflo(q4.z); qv[ks][5] = bfhi(q4.z); qv[ks][6] = bflo(q4.w); qv[ks][7] = bfhi(q4.w);
#pragma unroll
          for (int e = 0; e < 8; ++e) ss += qv[ks][e] * qv[ks][e]; }
      ss += __shfl_xor(ss, 16); ss += __shfl_xor(ss, 32);
      const float rs = rsqrtf(ss * (1.0f / 64.0f) + EPS) * 0.125f;
#pragma unroll
      for (int ks = 0; ks < 2; ++ks) { u32x4 o;
          o.x = cvt_pk_bf16(qv[ks][0] * rs * gq[ks][0], qv[ks][1] * rs * gq[ks][1]); o.y = cvt_pk_bf16(qv[ks][2] * rs * gq[ks][2], qv[ks][3] * rs * gq[ks][3]);
          o.z = cvt_pk_bf16(qv[ks][4] * rs * gq[ks][4], qv[ks][5] * rs * gq[ks][5]); o.w = cvt_pk_bf16(qv[ks][6] * rs * gq[ks][6], qv[ks][7] * rs * gq[ks][7]);
          qf[blk][ks] = __builtin_bit_cast(bf16x8, o); } }
    __syncthreads();
    attn_load(proj, N, tid, kr, vr, qr);
    const int ts = w < 6 ? w : 6;
#pragma unroll
    for (int blk = 0; blk < 2; ++blk) {
        const int nbk = I.nbk0 + blk; const size_t tokq = rowbase + (size_t)(nbk * 128 + qq) * d + r;
        f32x4 s[10]; float mx = -INFINITY;
#pragma unroll
        for (int tt = 0; tt < 10; ++tt) { const int kt = ts + tt; f32x4 a4 = (f32x4){0.f, 0.f, 0.f, 0.f};
#pragma unroll
            for (int ks = 0; ks < 2; ++ks) { const bf16x8 a = *(const LAS bf16x8*)(KS + ((blk * 8 + kt) * 16 + fr) * KLD + ks * 32 + 8 * fq); a4 = __builtin_amdgcn_mfma_f32_16x16x32_bf16(a, qf[blk][ks], a4, 0, 0, 0); }
#pragma unroll
            for (int i = 0; i < 4; ++i) { const int kk = kt * 16 + 4 * fq + i; const int dist = 128 + qq - kk; const int km = nbk * 128 - 128 + kk;
                const bool ok = (dist >= 0) && (dist <= 128) && (km >= 0); a4[i] = ok ? a4[i] : -INFINITY; mx = fmaxf(mx, a4[i]); }
            s[tt] = a4; }
        mx = fmaxf(mx, __shfl_xor(mx, 16)); mx = fmaxf(mx, __shfl_xor(mx, 32));
        float den = 0.f;
#pragma unroll
        for (int tt = 0; tt < 10; ++tt)
#pragma unroll
            for (int i = 0; i < 4; ++i) { const float e = __expf(s[tt][i] - mx); s[tt][i] = e; den += e; }
        den += __shfl_xor(den, 16); den += __shfl_xor(den, 32);
        f32x4 ao[4];
#pragma unroll
        for (int mt = 0; mt < 4; ++mt) ao[mt] = (f32x4){0.f, 0.f, 0.f, 0.f};
#pragma unroll
        for (int kp = 0; kp < 5; ++kp) {
            u32x4 pk; pk.x = cvt_pk_bf16(s[2 * kp][0], s[2 * kp][1]); pk.y = cvt_pk_bf16(s[2 * kp][2], s[2 * kp][3]); pk.z = cvt_pk_bf16(s[2 * kp + 1][0], s[2 * kp + 1][1]); pk.w = cvt_pk_bf16(s[2 * kp + 1][2], s[2 * kp + 1][3]);
            const bf16x8 pb = __builtin_bit_cast(bf16x8, pk);
#pragma unroll
            for (int mt = 0; mt < 4; ++mt) { const LAS bf16_t* vp = VT + (mt * 16 + fr) * VLD + blk * 128 + (ts + 2 * kp) * 16 + 4 * fq;
                const u32x2 lo = *(const LAS u32x2*)vp; const u32x2 hi = *(const LAS u32x2*)(vp + 16);
                u32x4 av; av.x = lo.x; av.y = lo.y; av.z = hi.x; av.w = hi.y;
                ao[mt] = __builtin_amdgcn_mfma_f32_16x16x32_bf16(__builtin_bit_cast(bf16x8, av), pb, ao[mt], 0, 0, 0); } }
        const float inv = __builtin_amdgcn_rcpf(den);
#pragma unroll
        for (int mt = 0; mt < 4; ++mt) { u32x2 o; o.x = cvt_pk_bf16(ao[mt][0] * inv, ao[mt][1] * inv); o.y = cvt_pk_bf16(ao[mt][2] * inv, ao[mt][3] * inv);
            if (!dry) *(u32x2*)(proj + tokq * PLD + qcol + mt * 16 + 4 * fq) = o; }
        if (fq == 0 && !dry) lse[((size_t)gi * T + tokq) * 8 + h] = mx + __logf(den);
    }
}

__device__ __forceinline__ void phase_mixer(const Params& p, LAS unsigned char* lds, int dry, int which) {
    const int nb = p.T / SEQ; const int nssd = nb * SSD_HEADS; const int nattn = nb * 3 * 8 * 16; const int G = (int)gridDim.x;
    int it = obid();
    for (; it < nssd; it += G) { if (which & 1) { const int x8 = it & 7, y8 = it >> 3; ssd_item(p, lds, y8 >> 2, 4 * x8 + (y8 & 3), dry); } }
    if ((which & 2) && it < nssd + nattn) {
        const bf16_t* proj = (const bf16_t*)(p.ws + ws_proj(p.T)); const int tid = otid();
        float gk[8], gq[2][8];
#pragma unroll
        for (int e = 0; e < 8; ++e) { gk[e] = p.k_norm_g[(tid & 7) * 8 + e]; gq[0][e] = p.q_norm_g[8 * ((tid & 63) >> 4) + e]; gq[1][e] = p.q_norm_g[32 + 8 * ((tid & 63) >> 4) + e]; }
        u32x4 kr[6], vr[6], qr[2][2];
        AttnItem I = attn_decode(it - nssd);
        attn_load(proj, I, tid, kr, vr, qr);
        for (; it < nssd + nattn; it += G) {
            const bool has_next = it + G < nssd + nattn;
            const AttnItem N = attn_decode(has_next ? it + G - nssd : it - nssd);
            attn_item(p, lds, I, N, kr, vr, qr, gk, gq, dry);
            I = N;
        }
    }
    __syncthreads();
}

__device__ __forceinline__ void phase_post(const Params& p) {
    const int T = p.T; bf16_t* proj = (bf16_t*)(p.ws + ws_proj(T)); const float* lse = (const float*)(p.ws + ws_lse(T));
    const size_t gtid = (size_t)obid() * 512 + otid(), gn = (size_t)gridDim.x * 512;
    for (size_t idx0 = gtid; idx0 < (size_t)T * 64; idx0 += 4 * gn) {
        u32x4 va[4], vb[4], vc[4]; float l0[4], l1[4], l2[4];
#pragma unroll
        for (int q = 0; q < 4; ++q) { const size_t idx = (idx0 + q * gn < (size_t)T * 64) ? idx0 + q * gn : idx0; const size_t t = idx >> 6; const int h = (int)(idx >> 3) & 7, piece = (int)idx & 7;
            l0[q] = lse[(t) * 8 + h]; l1[q] = lse[((size_t)T + t) * 8 + h]; l2[q] = lse[((size_t)2 * T + t) * 8 + h];
            const bf16_t* bp = proj + t * PLD + COL_Q + h * 64 + piece * 8; va[q] = *(const u32x4*)bp; vb[q] = *(const u32x4*)(bp + 512); vc[q] = *(const u32x4*)(bp + 1024); }
#pragma unroll
        for (int q = 0; q < 4; ++q) { const size_t idx = idx0 + q * gn; if (idx >= (size_t)T * 64) break; const size_t t = idx >> 6; const int h = (int)(idx >> 3) & 7, piece = (int)idx & 7;
            const float m = fmaxf(l0[q], fmaxf(l1[q], l2[q])); float e0 = __expf(l0[q] - m), e1 = __expf(l1[q] - m), e2 = __expf(l2[q] - m); const float inv = __builtin_amdgcn_rcpf(e0 + e1 + e2); e0 *= inv; e1 *= inv; e2 *= inv;
            const u32x4 a = va[q], b = vb[q], c = vc[q];
            u32x4 o;
            o.x = cvt_pk_bf16(e0 * bflo(a.x) + e1 * bflo(b.x) + e2 * bflo(c.x), e0 * bfhi(a.x) + e1 * bfhi(b.x) + e2 * bfhi(c.x));
            o.y = cvt_pk_bf16(e0 * bflo(a.y) + e1 * bflo(b.y) + e2 * bflo(c.y), e0 * bfhi(a.y) + e1 * bfhi(b.y) + e2 * bfhi(c.y));
            o.z = cvt_pk_bf16(e0 * bflo(a.z) + e1 * bflo(b.z) + e2 * bflo(c.z), e0 * bfhi(a.z) + e1 * bfhi(b.z) + e2 * bfhi(c.z));
            o.w = cvt_pk_bf16(e0 * bflo(a.w) + e1 * bflo(b.w) + e2 * bflo(c.w), e0 * bfhi(a.w) + e1 * bfhi(b.w) + e2 * bfhi(c.w));
            *(u32x4*)(proj + t * PLD + COL_Q + h * 64 + piece * 8) = o; }
    }
    { float* rowss = (float*)(p.ws + ws_dt(T)); for (size_t i = gtid; i < (size_t)T; i += gn) rowss[i] = 0.f; }
    const int l32 = otid() & 31;
    for (size_t hw0 = gtid >> 5; hw0 < (size_t)T * 8; hw0 += 4 * (gn >> 5)) {
        u32x4 av[4];
#pragma unroll
        for (int q = 0; q < 4; ++q) { const size_t hw = hw0 + q * (gn >> 5); av[q] = *(const u32x4*)(proj + (hw >> 3) * PLD + COL_Z + ((int)hw & 7) * 256 + l32 * 8); }
#pragma unroll
        for (int q = 0; q < 4; ++q) { const size_t hw = hw0 + q * (gn >> 5); const size_t t = hw >> 3; const int g = (int)hw & 7;
            const u32x4 a = av[q];
            float v[8]; v[0] = bflo(a.x); v[1] = bfhi(a.x); v[2] = bflo(a.y); v[3] = bfhi(a.y); v[4] = bflo(a.z); v[5] = bfhi(a.z); v[6] = bflo(a.w); v[7] = bfhi(a.w);
            float ss = 0.f;
#pragma unroll
            for (int e = 0; e < 8; ++e) ss += v[e] * v[e];
            ss += dppf<0xB1>(ss, ss); ss += dppf<0x4E>(ss, ss); ss += dppf<0x141>(ss, ss); ss += dppf<0x140>(ss, ss); ss += __shfl_xor(ss, 16);
            const float rs = rsqrtf(ss * (1.0f / 256.0f) + EPS);
            const float* gp = p.ssd_norm_g + g * 256 + l32 * 8;
            u32x4 o; o.x = cvt_pk_bf16(v[0] * rs * gp[0], v[1] * rs * gp[1]); o.y = cvt_pk_bf16(v[2] * rs * gp[2], v[3] * rs * gp[3]);
            o.z = cvt_pk_bf16(v[4] * rs * gp[4], v[5] * rs * gp[5]); o.w = cvt_pk_bf16(v[6] * rs * gp[6], v[7] * rs * gp[7]);
            *(u32x4*)(proj + t * PLD + COL_Z + g * 256 + l32 * 8) = o; }
    }
}

__device__ __forceinline__ void phase_fixup(const Params& p) {
    const int T = p.T; const bf16_t* side = (const bf16_t*)(p.ws + ws_proj(T) + (size_t)T * 18944); bf16_t* act = (bf16_t*)(p.ws + ws_proj(T) + (size_t)T * 11264);
    const size_t gtid = (size_t)obid() * 512 + otid(), gn = (size_t)gridDim.x * 512;
    for (size_t idx = gtid; idx < (size_t)(T / 64) * 352; idx += gn) {
        const size_t sl = idx / 352; const int cgp = (int)(idx % 352); const int c0 = cgp * 8; const int tile = c0 >> 7, within = c0 & 127; const int ndg = tile * 256 + within;
        const bool first = ((sl * 64) % SEQ) == 0; const size_t slp = first ? sl : sl - 1;
        const bf16_t* s0 = side + sl * 4 * 5632 + ndg; const bf16_t* sp = side + slp * 4 * 5632 + ndg;
        u32x4 g[4], v[4];
        g[0] = *(const u32x4*)(sp + 2 * 5632); v[0] = *(const u32x4*)(sp + 2 * 5632 + 128);
        g[1] = *(const u32x4*)(sp + 3 * 5632); v[1] = *(const u32x4*)(sp + 3 * 5632 + 128);
        g[2] = *(const u32x4*)(s0); v[2] = *(const u32x4*)(s0 + 128);
        g[3] = *(const u32x4*)(s0 + 5632); v[3] = *(const u32x4*)(s0 + 5632 + 128);
        if (first) { g[0] = (u32x4){0u, 0u, 0u, 0u}; g[1] = g[0]; v[0] = g[0]; v[1] = g[0]; }
        float wg[3][8], wv[3][8], bg[8], bv[8];
#pragma unroll
        for (int i = 0; i < 3; ++i)
#pragma unroll
            for (int e = 0; e < 8; ++e) { wg[i][e] = p.ffn_conv_w[i * 5632 + c0 + e]; wv[i][e] = p.ffn_conv_w[i * 5632 + D_FF + c0 + e]; }
#pragma unroll
        for (int e = 0; e < 8; ++e) { bg[e] = p.ffn_conv_b[c0 + e]; bv[e] = p.ffn_conv_b[D_FF + c0 + e]; }
#pragma unroll
        for (int j = 0; j < 2; ++j) {
            const u32x4 a2 = g[j], a1 = g[j + 1], a0 = g[j + 2], c2 = v[j], c1 = v[j + 1], c0v = v[j + 2];
            float o[8];
#define CG1(e, fa, fb) { const float ug_ = bg[e] + wg[0][e] * fa(a2.fb) + wg[1][e] * fa(a1.fb) + wg[2][e] * fa(a0.fb); const float uv_ = bv[e] + wv[0][e] * fa(c2.fb) + wv[1][e] * fa(c1.fb) + wv[2][e] * fa(c0v.fb); o[e] = siluf_(ug_) * uv_; }
            CG1(0, bflo, x) CG1(1, bfhi, x) CG1(2, bflo, y) CG1(3, bfhi, y) CG1(4, bflo, z) CG1(5, bfhi, z) CG1(6, bflo, w) CG1(7, bfhi, w)
#undef CG1
            u32x4 ow; ow.x = cvt_pk_bf16(o[0], o[1]); ow.y = cvt_pk_bf16(o[2], o[3]); ow.z = cvt_pk_bf16(o[4], o[5]); ow.w = cvt_pk_bf16(o[6], o[7]);
            *(u32x4*)(act + (sl * 64 + j) * D_FF + c0) = ow;
        }
    }
}

#define XB_TMO      128
#define XB_XCNT(j)  (256  + 64 * (j))
#define XB_XSUB(j)  (1280 + 64 * (j))
#define XB_XGEN(j)  (2304 + 64 * (j))
#define XB_TOP      3328
#define XB_TOPGEN   3392
#define XCD_BAR_WORDS 3456
#define XB_SPIN_CAP (1u << 22)
__device__ __forceinline__ unsigned xb_ld(unsigned* p)              { return __hip_atomic_load(p, __ATOMIC_RELAXED, __HIP_MEMORY_SCOPE_AGENT); }
__device__ __forceinline__ unsigned xb_add(unsigned* p, unsigned v) { return __hip_atomic_fetch_add(p, v, __ATOMIC_RELAXED, __HIP_MEMORY_SCOPE_AGENT); }
__device__ __forceinline__ unsigned xb_xcc_id() { return (unsigned)__builtin_amdgcn_s_getreg((3 << 11) | 20) & 0xFu; }
#define XB_SPIN(cond, bar) do { unsigned _sp = 0; while (cond) { __builtin_amdgcn_s_sleep(1); \
    if ((++_sp & 255u) == 0u) { if (xb_ld(&(bar)[XB_TMO])) break; if (_sp > XB_SPIN_CAP) { atomicAdd(&(bar)[XB_TMO], 1u); break; } } } } while (0)
struct XcdBarrier { unsigned* bar; unsigned x; volatile LAS unsigned* st; };
__device__ __forceinline__ XcdBarrier xcd_barrier_post(unsigned* bar, volatile LAS unsigned* st) {
    XcdBarrier b; b.bar = bar; b.x = xb_xcc_id(); b.st = st;
    if (threadIdx.x == 0) (void)xb_add(&bar[XB_XCNT(b.x)], 1u);
    return b;
}
__device__ __forceinline__ void xcd_barrier_complete(unsigned* bar, unsigned x, unsigned& nloc, unsigned& nx) {
    const unsigned G = gridDim.x * gridDim.y * gridDim.z;
    unsigned sum, cnt, mine, sp = 0u;
    for (;;) {
        sum = 0u; cnt = 0u; mine = 0u;
#pragma unroll
        for (unsigned j = 0; j < 16; ++j) { const unsigned c = xb_ld(&bar[XB_XCNT(j)]); sum += c; cnt += (c > 0u) ? 1u : 0u; mine = (j == x) ? c : mine; }
        if (sum == G) break;
        __builtin_amdgcn_s_sleep(1);
        if ((++sp & 255u) == 0u) { if (xb_ld(&bar[XB_TMO])) break; if (sp > XB_SPIN_CAP) { atomicAdd(&bar[XB_TMO], 1u); break; } }
    }
    nloc = mine > 0u ? mine : 1u; nx = cnt > 0u ? cnt : 1u;
}
__device__ __forceinline__ void xcd_barrier(const XcdBarrier& b) {
    asm volatile("s_waitcnt vmcnt(0)" ::: "memory");
    __syncthreads();
    if (threadIdx.x == 0) {
        unsigned* bar = b.bar;
        __builtin_amdgcn_s_waitcnt(0);
        unsigned nloc = b.st[0], nx = b.st[1];
        if (nloc == 0u) { xcd_barrier_complete(bar, b.x, nloc, nx); b.st[0] = nloc; b.st[1] = nx; }
        const unsigned old = xb_add(&bar[XB_XSUB(b.x)], 1u);
        const unsigned gen = old / nloc;
        if (old + 1u == (gen + 1u) * nloc) {
            __builtin_amdgcn_fence(__ATOMIC_RELEASE, "agent");
            asm volatile("s_waitcnt vmcnt(0)" ::: "memory");
            const unsigned og = xb_add(&bar[XB_TOP], 1u);
            const unsigned tg = og / nx;
            if (og + 1u == (tg + 1u) * nx) xb_add(&bar[XB_TOPGEN], 1u);
            else XB_SPIN(xb_ld(&bar[XB_TOPGEN]) == tg, bar);
            __builtin_amdgcn_fence(__ATOMIC_ACQUIRE, "agent");
            xb_add(&bar[XB_XGEN(b.x)], 1u);
            asm volatile("s_waitcnt vmcnt(0)" ::: "memory");
        } else {
            XB_SPIN(xb_ld(&bar[XB_XGEN(b.x)]) == gen, bar);
            __builtin_amdgcn_fence(__ATOMIC_ACQUIRE, "agent");
            asm volatile("s_waitcnt vmcnt(0)" ::: "memory");
        }
    }
    __syncthreads();
}

constexpr int PH_PER_CHUNK = 10;
__global__ void __launch_bounds__(512) fwd_megakernel(Params p_in) {
    extern __shared__ __attribute__((aligned(16))) unsigned char smem[];
    LAS unsigned char* lds = (LAS unsigned char*)smem;
    cg::grid_group grid = cg::this_grid();
    volatile LAS unsigned* xbst = (volatile LAS unsigned*)(lds + LDS_BYTES - 16);
    if (threadIdx.x == 0) { xbst[0] = 0u; xbst[1] = 0u; }
    __syncthreads();
    XcdBarrier xb = xcd_barrier_post((unsigned*)(p_in.ws + WS_BAR), xbst);
#define GRID_SYNC() do { if (p.nchunks < 0) grid.sync(); xcd_barrier(xb); } while (0)
    Params p = p_in;
    for (int ph = p.ph_lo; ph < p.ph_hi; ++ph) {
        { size_t z_ = 0; asm volatile("" : "+s"(p.T), "+s"(z_)); p.ws = p_in.ws + z_; }
        const int T = p.T;
        const int chunk = ph / PH_PER_CHUNK, k = ph % PH_PER_CHUNK;
        const size_t tok0 = (size_t)chunk * T;
        bf16_t* H = (bf16_t*)(p.ws + ws_h(T)); bf16_t* PROJ = (bf16_t*)(p.ws + ws_proj(T));
        bf16_t* U = PROJ; bf16_t* ACT = (bf16_t*)(p.ws + ws_proj(T) + (size_t)T * 11264); bf16_t* X1B = (bf16_t*)(p.ws + ws_proj(T) + (size_t)T * 16896);
        float* xout = p.out + tok0 * 1024; const float* xin = p.x + tok0 * 1024;
        for (int rep = ((p.pad0 >> k) & 1); rep >= 0; --rep) {
        if (rep) { size_t z_ = 0; asm volatile("" : "+s"(p.T), "+s"(z_)); p.ws = p_in.ws + z_; }
        switch (k) {
#ifndef PHASE_MASK
#define PHASE_MASK 1023
#endif
#define EN(k_) if (!((PHASE_MASK >> (k_)) & 1)) break;
        case 0: EN(0) if (chunk == 0) phase_wprep(p, lds); phase_rms(xin, p.norm1_g, H, T); break;
        case 1: EN(1) { EpiInproj E; E.O = PROJ; E.dt = (float*)(p.ws + ws_dt(T)); run_gemm(lds, H, 1024, (const bf16_t*)(p.ws + WS_WIN), T, N_IN_PAD, 1024, E); } break;
        case 2: EN(2) phase_mixer(p, lds, rep, rep ? p.pad1 : 3); break;
        case 3: EN(3) phase_post(p); break;
        case 4: EN(4) { EpiGate<0> E0; E0.O = H; E0.G = PROJ + COL_GS; run_gemm(lds, PROJ + COL_Z, PLD, (const bf16_t*)(p.ws + WS_WSP), T, 1024, 2048, E0);
                  EpiGate<1> E1; E1.O = H; E1.G = PROJ + COL_GA; run_gemm(lds, PROJ + COL_Q, PLD, (const bf16_t*)(p.ws + WS_WAP), T, 1024, 512, E1); } break;
        case 5: EN(5) { EpiOut E; E.dst = xout; E.src = xin; E.xb = X1B; E.rowss = (float*)(p.ws + ws_dt(T)); run_gemm(lds, H, 1024, (const bf16_t*)(p.ws + WS_WOUT), T, 1024, 1024, E); } break;
        case 6: break;
        case 7: EN(7) { EpiUpConv E; E.act = ACT; E.side = (bf16_t*)(p.ws + ws_proj(T) + (size_t)T * 18944); E.rowss = (const float*)(p.ws + ws_dt(T)); E.cw = p.ffn_conv_w; E.cbias = p.ffn_conv_b;
                  run_gemm(lds, X1B, 1024, (const bf16_t*)(p.ws + WS_WUP), T, 5632, 1024, E); } break;
        case 8: EN(8) phase_fixup(p); break;
        case 9: EN(9) { EpiDown E; E.dst = xout; E.xb = X1B; run_gemm(lds, ACT, D_FF, (const bf16_t*)(p.ws + WS_WDN), T, 1024, D_FF, E); } break;
        }
        if (rep) GRID_SYNC();
        }
#ifndef SYNC_REP
#define SYNC_REP 1
#endif
        if (ph + 1 < p.ph_hi && k != PH_PER_CHUNK - 1 && k != 6) for (int sr = 0; sr < SYNC_REP; ++sr) GRID_SYNC();
    }
}

#ifndef MK_PER_PHASE_LAUNCH
#define MK_PER_PHASE_LAUNCH 0
#endif
extern "C" void kernel_launch(void* const* d_in, const int* in_sizes, int n_in, void* d_out, int out_size, void* d_ws, size_t ws_size, hipStream_t stream) {
    static int grid_blocks = 0;
    if (!grid_blocks) {
        int dev = 0, cus = 0, per_cu = 0;
        hipGetDevice(&dev);
        hipDeviceGetAttribute(&cus, hipDeviceAttributeMultiprocessorCount, dev);
        hipFuncSetAttribute((const void*)fwd_megakernel, hipFuncAttributeMaxDynamicSharedMemorySize, LDS_BYTES);
        hipOccupancyMaxActiveBlocksPerMultiprocessor(&per_cu, (const void*)fwd_megakernel, 512, LDS_BYTES);
        if (per_cu < 1) { fprintf(stderr, "occupancy query says %d blocks per CU\n", per_cu); per_cu = 1; }
        grid_blocks = cus * 1;
        (void)hipGetLastError();
    }
    if (hipMemsetAsync((char*)d_ws + WS_BAR, 0, WS_BAR_BYTES, stream) != hipSuccess) fprintf(stderr, "memset of barrier words failed\n");
    Params p{};
    const float** pp = (const float**)&p;
    for (int i = 0; i < 19; ++i) pp[i] = (const float*)d_in[i];
    p.out = (float*)d_out; p.ws = (unsigned char*)d_ws;
    int nb = 8;
    while (nb > 1 && ws_total(nb * SEQ) > ws_size) nb >>= 1;
    p.T = nb * SEQ; p.nchunks = BATCH / nb;
#ifndef DUP_MASK
#define DUP_MASK 0
#endif
#ifndef DUP_WHICH
#define DUP_WHICH 3
#endif
    p.pad0 = DUP_MASK; p.pad1 = DUP_WHICH;
    const int nph = p.nchunks * PH_PER_CHUNK;
#if MK_PER_PHASE_LAUNCH
    for (int ph = 0; ph < nph; ++ph) { p.ph_lo = ph; p.ph_hi = ph + 1; hipLaunchKernelGGL(fwd_megakernel, dim3(grid_blocks), dim3(512), LDS_BYTES, stream, p); }
#else
    p.ph_lo = 0; p.ph_hi = nph;
    void* args[] = {&p};
    hipError_t e = hipLaunchCooperativeKernel((const void*)fwd_megakernel, dim3(grid_blocks), dim3(512), args, LDS_BYTES, stream);
    if (e != hipSuccess) fprintf(stderr, "cooperative launch failed: %s (grid %d)\n", hipGetErrorString(e), grid_blocks);
#endif
}
```

```cpp
#include <hip/hip_runtime.h>
#include <hip/hip_cooperative_groups.h>
#include <cstdio>
#include <cstdint>
namespace cg = cooperative_groups;

namespace pg8 {
#define PG8_LAS __attribute__((address_space(3)))
typedef unsigned short bf16_t;
typedef short bf16x8 __attribute__((ext_vector_type(8)));
typedef float f32x4 __attribute__((ext_vector_type(4)));
typedef float f32x16 __attribute__((ext_vector_type(16)));
typedef unsigned u32x4 __attribute__((ext_vector_type(4)));
typedef unsigned u32x2 __attribute__((ext_vector_type(2)));
constexpr int BM = 256, BK = 64, HALF = 128, HTB = HALF * BK * 2, STAGE_BYTES = 8 * HTB, NXCD = 8, WGM = 8;

__host__ __device__ __forceinline__ int lds_byte(int r, int c) { const int st = (r >> 4) * 2 + (c >> 5), rr = r & 15, cc = c & 31, ob = rr * 64 + cc * 2; return st * 1024 + (ob ^ (((ob >> 9) & 1) << 5)); }
__host__ __device__ __forceinline__ void stage_rc(int b, int& R, int& C) { const int st = b / 1024, sb = b % 1024, swz = sb ^ (((sb >> 9) & 1) << 5); R = (st >> 1) * 16 + swz / 64; C = (st & 1) * 32 + (swz % 64) / 2; }
__host__ __device__ __forceinline__ int perm32(int rho) { const int n = rho >> 4, i = rho & 15; return 8 * (i >> 2) + 4 * n + (i & 3); }

struct Unit { int pm, pn; };
struct Gemm { const bf16_t* A; const bf16_t* Bt; int M, N, K, lda; };

struct StaticOrder {
    int nM, nN, nwg, G, c;
    __host__ __device__ void init(int M, int N, int G_, int c_) { nM = M / BM; nN = N / BM; nwg = nM * nN; G = G_; c = c_; }
    __host__ __device__ bool next(int i, Unit& u) const {
        const long L = (long)i * G + c; if (L >= nwg) return false;
        int wgid = (int)L; { const int q = nwg / NXCD, r = nwg % NXCD, xcd = wgid % NXCD, off = wgid / NXCD; wgid = (xcd < r ? xcd * (q + 1) : r * (q + 1) + (xcd - r) * q) + off; }
        const int nig = WGM * nN, gid = wgid / nig, fm = gid * WGM, gsz = (nM - fm) < WGM ? (nM - fm) : WGM;
        u.pm = fm + ((wgid % nig) % gsz); u.pn = (wgid % nig) / gsz; return true;
    }
    __device__ __forceinline__ void a_ready(const Unit&) const {}
    __device__ __forceinline__ void done(const Unit&) const {}
};

__device__ __forceinline__ unsigned cvt_pk_bf16(float lo, float hi) { unsigned r; asm volatile("v_cvt_pk_bf16_f32 %0, %1, %2" : "=v"(r) : "v"(lo), "v"(hi)); return r; }

template <class Epi, class Sched>
__device__ __forceinline__ void gemm_phase(PG8_LAS unsigned char* lds, const Gemm g, const Sched& S, const Epi& E) {
    int tid_ = threadIdx.x; asm volatile("" : "+v"(tid_));
    const int tid = tid_, wid = __builtin_amdgcn_readfirstlane(tid >> 6), lane = tid & 63, wr = wid >> 2, wc = wid & 3, fr = lane & 15, fq = lane >> 4;
    const int K = g.K, nt = K / BK, lda = g.lda;
    unsigned voffA[2], voffB[2];
#pragma unroll
    for (int i = 0; i < 2; ++i) { int R, C; stage_rc(tid * 16 + i * 8192, R, C); const int Rb = Epi::PERM ? ((R & ~31) + perm32(R & 31)) : R;
        voffA[i] = (unsigned)(R * lda + C) * 2u; voffB[i] = (unsigned)(Rb * K + C) * 2u; }
    const size_t kstep = (size_t)(BK * 2);
    const size_t hstepA = (size_t)HALF * lda * 2, hstepB = (size_t)HALF * K * 2;
    const size_t tstepA = 2 * hstepA, tstepB = 2 * hstepB;
    const unsigned ldsw = (unsigned)wid * 1024u;
    const int aoff = lds_byte(wr * 64 + fr, fq * 8), boff = lds_byte(wc * 32 + fr, fq * 8);
#define PG8_SA(b, h) (((b) * 2 + (h)) * HTB)
#define PG8_SB(b, h) ((4 + (b) * 2 + (h)) * HTB)
#define PG8_STAGE(bufoff, gbase, voff) do { _Pragma("unroll") for (int _i = 0; _i < 2; ++_i) \
        __builtin_amdgcn_global_load_lds((const unsigned*)((const char*)(gbase) + (voff)[_i]), (PG8_LAS unsigned*)(lds + (bufoff) + ldsw + _i * 8192), 16, 0, 0); } while (0)
#define PG8_LDA(dst, b, h) do { _Pragma("unroll") for (int m = 0; m < 4; ++m) _Pragma("unroll") for (int k = 0; k < 2; ++k) dst[m][k] = *(const PG8_LAS bf16x8*)(lds + PG8_SA(b, h) + aoff + m * 2048 + k * 1024); } while (0)
#define PG8_LDB(dst, b, h) do { _Pragma("unroll") for (int n = 0; n < 2; ++n) _Pragma("unroll") for (int k = 0; k < 2; ++k) dst[n][k] = *(const PG8_LAS bf16x8*)(lds + PG8_SB(b, h) + boff + n * 2048 + k * 1024); } while (0)
#define PG8_MMA(ai, bj, At, Bt) do { __builtin_amdgcn_s_setprio(1); _Pragma("unroll") for (int m = 0; m < 4; ++m) _Pragma("unroll") for (int n = 0; n < 2; ++n) _Pragma("unroll") for (int k = 0; k < 2; ++k) \
        acc[ai][bj][m][n] = __builtin_amdgcn_mfma_f32_16x16x32_bf16(Bt[n][k], At[m][k], acc[ai][bj][m][n], 0, 0, 0); __builtin_amdgcn_s_setprio(0); } while (0)
#define PG8_WAIT_V(n) asm volatile("s_waitcnt vmcnt(" #n ")" ::: "memory")
#define PG8_WAIT_L(n) asm volatile("s_waitcnt lgkmcnt(" #n ")" ::: "memory")
#define PG8_BAR __builtin_amdgcn_s_barrier()
#define PG8_SCHED __builtin_amdgcn_sched_barrier(0)
    Unit cur, nxt; int ui = 0;
    if (!S.next(0, cur)) return;
    f32x4 acc[2][2][4][2];
#pragma unroll
    for (int a = 0; a < 2; ++a)
#pragma unroll
        for (int b = 0; b < 2; ++b)
#pragma unroll
            for (int m = 0; m < 4; ++m)
#pragma unroll
                for (int n = 0; n < 2; ++n) acc[a][b][m][n] = (f32x4){0.f, 0.f, 0.f, 0.f};
    bf16x8 At[4][2], B0[2][2], B1[2][2];
    const char* cA = (const char*)g.A + (size_t)cur.pm * tstepA; const char* cB = (const char*)g.Bt + (size_t)cur.pn * tstepB;
    S.a_ready(cur);
    PG8_STAGE(PG8_SB(0, 0), cB, voffB); PG8_STAGE(PG8_SA(0, 0), cA, voffA); PG8_STAGE(PG8_SB(0, 1), cB + hstepB, voffB); PG8_STAGE(PG8_SA(0, 1), cA + hstepA, voffA);
    if (wr == 1) PG8_BAR;
    PG8_WAIT_V(4); PG8_BAR;
    PG8_STAGE(PG8_SB(1, 0), cB + kstep, voffB); PG8_STAGE(PG8_SA(1, 0), cA + kstep, voffA); PG8_STAGE(PG8_SB(1, 1), cB + hstepB + kstep, voffB);
    PG8_WAIT_V(6); PG8_BAR;
    for (;;) {
        const bool has_next = S.next(ui + 1, nxt);
        const char* nA = has_next ? (const char*)g.A + (size_t)nxt.pm * tstepA : cA; const char* nB = has_next ? (const char*)g.Bt + (size_t)nxt.pn * tstepB : cB;
        for (int t = 0; t < nt; t += 2) {
            const bool last = (t == nt - 2);
            const char* a1 = cA + (size_t)(t + 1) * kstep;
            const char* a2 = last ? nA : cA + (size_t)(t + 2) * kstep; const char* b2 = last ? nB : cB + (size_t)(t + 2) * kstep;
            const char* a3 = a2 + kstep; const char* b3 = b2 + kstep;
            if (last && has_next) S.a_ready(nxt);
            PG8_LDB(B0, 0, 0); PG8_SCHED; PG8_LDA(At, 0, 0); PG8_STAGE(PG8_SA(1, 1), a1 + hstepA, voffA);
            PG8_WAIT_L(8); PG8_BAR; PG8_WAIT_L(0); PG8_MMA(0, 0, At, B0); PG8_BAR; PG8_SCHED;
            PG8_LDB(B1, 0, 1); PG8_STAGE(PG8_SB(0, 0), b2, voffB);
            PG8_BAR; PG8_WAIT_L(0); PG8_MMA(0, 1, At, B1); PG8_BAR;
            PG8_LDA(At, 0, 1); PG8_STAGE(PG8_SA(0, 0), a2, voffA);
            PG8_BAR; PG8_WAIT_L(0); PG8_MMA(1, 0, At, B0); PG8_BAR; PG8_SCHED;
            PG8_STAGE(PG8_SB(0, 1), b2 + hstepB, voffB);
            PG8_WAIT_V(6); PG8_BAR; PG8_MMA(1, 1, At, B1); PG8_BAR;
            PG8_LDB(B0, 1, 0); PG8_SCHED; PG8_LDA(At, 1, 0); PG8_STAGE(PG8_SA(0, 1), a2 + hstepA, voffA);
            PG8_WAIT_L(8); PG8_BAR; PG8_WAIT_L(0); PG8_MMA(0, 0, At, B0); PG8_BAR; PG8_SCHED;
            PG8_LDB(B1, 1, 1); PG8_STAGE(PG8_SB(1, 0), b3, voffB);
            PG8_BAR; PG8_WAIT_L(0); PG8_MMA(0, 1, At, B1); PG8_BAR;
            PG8_LDA(At, 1, 1); PG8_STAGE(PG8_SA(1, 0), a3, voffA);
            PG8_BAR; PG8_WAIT_L(0); PG8_MMA(1, 0, At, B0); PG8_BAR; PG8_SCHED;
            PG8_STAGE(PG8_SB(1, 1), b3 + hstepB, voffB);
            PG8_WAIT_V(6); PG8_BAR; PG8_MMA(1, 1, At, B1); PG8_BAR;
        }
        E(acc, cur, wr, wc, fr, fq); S.done(cur);
        if (!has_next) break;
#pragma unroll
        for (int a = 0; a < 2; ++a)
#pragma unroll
            for (int b = 0; b < 2; ++b)
#pragma unroll
                for (int m = 0; m < 4; ++m)
#pragma unroll
                    for (int n = 0; n < 2; ++n) acc[a][b][m][n] = (f32x4){0.f, 0.f, 0.f, 0.f};
        cur = nxt; cA = nA; cB = nB; ++ui;
    }
    PG8_WAIT_V(0);
    if (wr == 0) PG8_BAR;
    PG8_BAR;
#undef PG8_SA
#undef PG8_SB
#undef PG8_STAGE
#undef PG8_LDA
#undef PG8_LDB
#undef PG8_MMA
#undef PG8_WAIT_V
#undef PG8_WAIT_L
#undef PG8_BAR
#undef PG8_SCHED
}
}

using pg8::bf16_t; using pg8::bf16x8; using pg8::f32x4; using pg8::f32x16; using pg8::u32x4; using pg8::u32x2; using pg8::Unit; using pg8::cvt_pk_bf16;
#define LAS __attribute__((address_space(3)))

constexpr int D_MODEL = 1024, SEQ = 4096, BATCH = 16;
constexpr int D_INNER = 2048, SSD_HEADS = 32, D_STATE = 128, CONV_DIM = 4096;
constexpr int D_FF = 2816;
constexpr int N_IN_SRC = 12832;
constexpr int N_IN_MAIN = 12800;
constexpr int N_IN_PAD = 13056;
constexpr int PLD = N_IN_MAIN;
constexpr int COL_Z = 0, COL_XBC = 2048, COL_Q = 6144, COL_GS = 10752, COL_GA = 11776;
constexpr float EPS = 1e-6f;
constexpr int LDS_BYTES = 147456;

constexpr size_t WS_BAR = 0;
constexpr size_t WS_BAR_BYTES = 16384;
constexpr size_t WS_WIN = WS_BAR_BYTES;
constexpr size_t WS_WSP = WS_WIN + (size_t)N_IN_PAD * 1024 * 2;
constexpr size_t WS_WAP = WS_WSP + (size_t)1024 * 2048 * 2;
constexpr size_t WS_WOUT = WS_WAP + (size_t)1024 * 512 * 2;
constexpr size_t WS_WUP = WS_WOUT + (size_t)1024 * 1024 * 2;
constexpr size_t WS_WDN = WS_WUP + (size_t)5632 * 1024 * 2;
constexpr size_t WS_ACT0 = WS_WDN + (size_t)1024 * 2816 * 2;
__host__ __device__ constexpr size_t ws_h(int T) { return WS_ACT0; }
__host__ __device__ constexpr size_t ws_dt(int T) { return ws_h(T) + (size_t)T * 2048; }
__host__ __device__ constexpr size_t ws_lse(int T) { return ws_dt(T) + (size_t)T * 128; }
__host__ __device__ constexpr size_t ws_proj(int T) { return ws_lse(T) + (size_t)T * 96; }
__host__ __device__ constexpr size_t ws_total(int T) { return ws_proj(T) + (size_t)T * 25600; }

struct Params {
    const float* x; const float* norm1_g; const float* w_in; const float* ssd_conv_w; const float* ssd_conv_b;
    const float* dt_bias; const float* a_log; const float* d_skip; const float* ssd_norm_g; const float* w_ssd_proj;
    const float* q_norm_g; const float* k_norm_g; const float* w_attn_proj; const float* w_out; const float* norm2_g;
    const float* w_up; const float* ffn_conv_w; const float* ffn_conv_b; const float* w_down;
    float* out; unsigned char* ws;
    int T, nchunks, ph_lo, ph_hi, pad0, pad1;
};

__device__ __forceinline__ float bf2f(unsigned short b) { return __uint_as_float(((unsigned)b) << 16); }
__device__ __forceinline__ float bflo(unsigned u) { return __uint_as_float(u << 16); }
__device__ __forceinline__ float bfhi(unsigned u) { return __uint_as_float(u & 0xffff0000u); }
__device__ __forceinline__ unsigned short f2bf(float f) { return (unsigned short)(cvt_pk_bf16(f, 0.f) & 0xffffu); }
__device__ __forceinline__ int otid() { int t = threadIdx.x; asm volatile("" : "+v"(t)); return t; }
__device__ __forceinline__ int obid() { int t = blockIdx.x; asm volatile("" : "+s"(t)); return t; }
__device__ __forceinline__ float sigmoidf_(float v) { return __builtin_amdgcn_rcpf(1.0f + __expf(-v)); }
__device__ __forceinline__ float siluf_(float v) { return v * __builtin_amdgcn_rcpf(1.0f + __expf(-v)); }
template <int CTRL> __device__ __forceinline__ float dppf(float old, float src) {
    return __builtin_bit_cast(float, __builtin_amdgcn_update_dpp(__builtin_bit_cast(int, old), __builtin_bit_cast(int, src), CTRL, 0xF, 0xF, false));
}

struct EpiInproj {
    static constexpr bool PERM = true;
    bf16_t* O; float* dt;
    __device__ __forceinline__ void operator()(const f32x4 (&acc)[2][2][4][2], const Unit& u, int wr, int wc, int fr, int fq) const {
        const int row0 = u.pm * 256 + wr * 64 + fr;
        if (u.pn < 50) {
            const int col0 = u.pn * 256 + wc * 32 + 8 * fq;
#pragma unroll
            for (int ai = 0; ai < 2; ++ai)
#pragma unroll
                for (int m = 0; m < 4; ++m) { bf16_t* rowp = O + (size_t)(row0 + ai * 128 + m * 16) * PLD + col0;
#pragma unroll
                    for (int bj = 0; bj < 2; ++bj) { const f32x4 v0 = acc[ai][bj][m][0], v1 = acc[ai][bj][m][1];
                        u32x4 w; w.x = cvt_pk_bf16(v0[0], v0[1]); w.y = cvt_pk_bf16(v0[2], v0[3]); w.z = cvt_pk_bf16(v1[0], v1[1]); w.w = cvt_pk_bf16(v1[2], v1[3]);
                        *(u32x4*)(rowp + bj * 128) = w; } }
        } else if (wc == 0) {
#pragma unroll
            for (int ai = 0; ai < 2; ++ai)
#pragma unroll
                for (int m = 0; m < 4; ++m) { float* rp = dt + (size_t)(row0 + ai * 128 + m * 16) * 32 + 8 * fq;
                    *(f32x4*)(rp) = acc[ai][0][m][0]; *(f32x4*)(rp + 4) = acc[ai][0][m][1]; }
        }
    }
};
template <int MODE  > struct EpiGate {
    static constexpr bool PERM = true;
    bf16_t* O; const bf16_t* G;
    __device__ __forceinline__ void operator()(const f32x4 (&acc)[2][2][4][2], const Unit& u, int wr, int wc, int fr, int fq) const {
        const int row0 = u.pm * 256 + wr * 64 + fr, col0 = u.pn * 256 + wc * 32 + 8 * fq;
#pragma unroll
        for (int ai = 0; ai < 2; ++ai) {
            u32x4 gq[4][2];
#pragma unroll
            for (int m = 0; m < 4; ++m)
#pragma unroll
                for (int bj = 0; bj < 2; ++bj) gq[m][bj] = *(const u32x4*)(G + (size_t)(row0 + ai * 128 + m * 16) * PLD + col0 + bj * 128);
#pragma unroll
            for (int mp = 0; mp < 2; ++mp) {
                u32x4 oq[2][2];
                if (MODE == 1) {
#pragma unroll
                    for (int mm = 0; mm < 2; ++mm)
#pragma unroll
                        for (int bj = 0; bj < 2; ++bj) oq[mm][bj] = *(const u32x4*)(O + (size_t)(row0 + ai * 128 + (mp * 2 + mm) * 16) * 1024 + col0 + bj * 128); }
#pragma unroll
                for (int mm = 0; mm < 2; ++mm)
#pragma unroll
                    for (int bj = 0; bj < 2; ++bj) { const int m = mp * 2 + mm; const size_t row = (size_t)(row0 + ai * 128 + m * 16);
                        const f32x4 v0 = acc[ai][bj][m][0], v1 = acc[ai][bj][m][1]; const u32x4 g4 = gq[m][bj];
                        float r[8];
                        r[0] = v0[0] * sigmoidf_(bflo(g4.x)); r[1] = v0[1] * sigmoidf_(bfhi(g4.x)); r[2] = v0[2] * sigmoidf_(bflo(g4.y)); r[3] = v0[3] * sigmoidf_(bfhi(g4.y));
                        r[4] = v1[0] * sigmoidf_(bflo(g4.z)); r[5] = v1[1] * sigmoidf_(bfhi(g4.z)); r[6] = v1[2] * sigmoidf_(bflo(g4.w)); r[7] = v1[3] * sigmoidf_(bfhi(g4.w));
                        if (MODE == 1) { const u32x4 o = oq[mm][bj];
                            r[0] += bflo(o.x); r[1] += bfhi(o.x); r[2] += bflo(o.y); r[3] += bfhi(o.y); r[4] += bflo(o.z); r[5] += bfhi(o.z); r[6] += bflo(o.w); r[7] += bfhi(o.w); }
                        u32x4 w; w.x = cvt_pk_bf16(r[0], r[1]); w.y = cvt_pk_bf16(r[2], r[3]); w.z = cvt_pk_bf16(r[4], r[5]); w.w = cvt_pk_bf16(r[6], r[7]);
                        *(u32x4*)(O + row * 1024 + col0 + bj * 128) = w; }
            }
        }
    }
};
struct EpiRes {
    static constexpr bool PERM = false;
    float* dst; const float* src;
    __device__ __forceinline__ void operator()(const f32x4 (&acc)[2][2][4][2], const Unit& u, int wr, int wc, int fr, int fq) const {
        const int row0 = u.pm * 256 + wr * 64 + fr, col0 = u.pn * 256 + wc * 32 + 4 * fq;
#pragma unroll
        for (int ai = 0; ai < 2; ++ai)
#pragma unroll
            for (int mp = 0; mp < 2; ++mp) {
                f32x4 sv[2][2][2];
#pragma unroll
                for (int mm = 0; mm < 2; ++mm) { const size_t off = (size_t)(row0 + ai * 128 + (mp * 2 + mm) * 16) * 1024 + col0;
#pragma unroll
                    for (int bj = 0; bj < 2; ++bj)
#pragma unroll
                        for (int n = 0; n < 2; ++n) sv[mm][bj][n] = *(const f32x4*)(src + off + bj * 128 + n * 16); }
#pragma unroll
                for (int mm = 0; mm < 2; ++mm) { const int m = mp * 2 + mm; const size_t off = (size_t)(row0 + ai * 128 + m * 16) * 1024 + col0;
#pragma unroll
                    for (int bj = 0; bj < 2; ++bj)
#pragma unroll
                        for (int n = 0; n < 2; ++n) *(f32x4*)(dst + off + bj * 128 + n * 16) = sv[mm][bj][n] + acc[ai][bj][m][n]; }
            }
    }
};
struct EpiOut {
    static constexpr bool PERM = false;
    float* dst; const float* src; bf16_t* xb; float* rowss;
    __device__ __forceinline__ void operator()(const f32x4 (&acc)[2][2][4][2], const Unit& u, int wr, int wc, int fr, int fq) const {
        const int row0 = u.pm * 256 + wr * 64 + fr, col0 = u.pn * 256 + wc * 32 + 4 * fq;
#pragma unroll
        for (int ai = 0; ai < 2; ++ai)
#pragma unroll
            for (int mp = 0; mp < 2; ++mp) {
                f32x4 sv[2][2][2];
#pragma unroll
                for (int mm = 0; mm < 2; ++mm) { const size_t off = (size_t)(row0 + ai * 128 + (mp * 2 + mm) * 16) * 1024 + col0;
#pragma unroll
                    for (int bj = 0; bj < 2; ++bj)
#pragma unroll
                        for (int n = 0; n < 2; ++n) sv[mm][bj][n] = *(const f32x4*)(src + off + bj * 128 + n * 16); }
#pragma unroll
                for (int mm = 0; mm < 2; ++mm) { const int m = mp * 2 + mm; const int row = row0 + ai * 128 + m * 16; const size_t off = (size_t)row * 1024 + col0; float ss = 0.f;
#pragma unroll
                    for (int bj = 0; bj < 2; ++bj)
#pragma unroll
                        for (int n = 0; n < 2; ++n) { const f32x4 v = sv[mm][bj][n] + acc[ai][bj][m][n];
                            ss += v[0] * v[0] + v[1] * v[1] + v[2] * v[2] + v[3] * v[3];
                            u32x2 o; o.x = cvt_pk_bf16(v[0], v[1]); o.y = cvt_pk_bf16(v[2], v[3]); *(u32x2*)(xb + off + bj * 128 + n * 16) = o; }
                    ss += __shfl_xor(ss, 16); ss += __shfl_xor(ss, 32);
                    if (fq == 0) atomicAdd(rowss + row, ss); }
            }
    }
};
struct EpiDown {
    static constexpr bool PERM = false;
    float* dst; const bf16_t* xb;
    __device__ __forceinline__ void operator()(const f32x4 (&acc)[2][2][4][2], const Unit& u, int wr, int wc, int fr, int fq) const {
        const int row0 = u.pm * 256 + wr * 64 + fr, col0 = u.pn * 256 + wc * 32 + 4 * fq;
#pragma unroll
        for (int ai = 0; ai < 2; ++ai) {
            u32x2 sv[4][2][2];
#pragma unroll
            for (int m = 0; m < 4; ++m) { const size_t off = (size_t)(row0 + ai * 128 + m * 16) * 1024 + col0;
#pragma unroll
                for (int bj = 0; bj < 2; ++bj)
#pragma unroll
                    for (int n = 0; n < 2; ++n) sv[m][bj][n] = *(const u32x2*)(xb + off + bj * 128 + n * 16); }
#pragma unroll
            for (int m = 0; m < 4; ++m) { const size_t off = (size_t)(row0 + ai * 128 + m * 16) * 1024 + col0;
#pragma unroll
                for (int bj = 0; bj < 2; ++bj)
#pragma unroll
                    for (int n = 0; n < 2; ++n) { const u32x2 x2 = sv[m][bj][n]; const f32x4 a = acc[ai][bj][m][n];
                        f32x4 o; o[0] = bflo(x2.x) + a[0]; o[1] = bfhi(x2.x) + a[1]; o[2] = bflo(x2.y) + a[2]; o[3] = bfhi(x2.y) + a[3];
                        *(f32x4*)(dst + off + bj * 128 + n * 16) = o; } }
        }
    }
};
struct EpiUp {
    static constexpr bool PERM = true;
    bf16_t* O; const float* rowss;
    __device__ __forceinline__ void operator()(const f32x4 (&acc)[2][2][4][2], const Unit& u, int wr, int wc, int fr, int fq) const {
        const int row0 = u.pm * 256 + wr * 64 + fr, col0 = u.pn * 256 + wc * 32 + 8 * fq;
        float rs[2][4];
#pragma unroll
        for (int ai = 0; ai < 2; ++ai)
#pragma unroll
            for (int m = 0; m < 4; ++m) rs[ai][m] = rowss[row0 + ai * 128 + m * 16];
#pragma unroll
        for (int ai = 0; ai < 2; ++ai)
#pragma unroll
            for (int m = 0; m < 4; ++m) { bf16_t* rowp = O + (size_t)(row0 + ai * 128 + m * 16) * 5632 + col0; const float r = rsqrtf(rs[ai][m] * (1.0f / 1024.0f) + EPS);
#pragma unroll
                for (int bj = 0; bj < 2; ++bj) { const f32x4 v0 = acc[ai][bj][m][0] * r, v1 = acc[ai][bj][m][1] * r;
                    u32x4 w; w.x = cvt_pk_bf16(v0[0], v0[1]); w.y = cvt_pk_bf16(v0[2], v0[3]); w.z = cvt_pk_bf16(v1[0], v1[1]); w.w = cvt_pk_bf16(v1[2], v1[3]);
                    *(u32x4*)(rowp + bj * 128) = w; } }
    }
};
struct EpiUpConv {
    static constexpr bool PERM = true;
    bf16_t* act; bf16_t* side; const float* rowss; const float* cw; const float* cbias;
    struct W8 { f32x4 wg[3], wv[3], bg, bv; };
    __device__ __forceinline__ void loadw(W8& w, int c) const {
#pragma unroll
        for (int i = 0; i < 3; ++i) { w.wg[i] = *(const f32x4*)(cw + i * 5632 + c); w.wv[i] = *(const f32x4*)(cw + i * 5632 + D_FF + c); }
        w.bg = *(const f32x4*)(cbias + c); w.bv = *(const f32x4*)(cbias + D_FF + c);
    }
    template <int N> __device__ __forceinline__ void half(const f32x4 (&acc)[2][2][4][2], const W8& w, const float (&rs)[2][4], int ai, const Unit& u, int wr, int wc, int fr, int fq) const {
        const int row0 = u.pm * 256 + wr * 64 + fr; const int cu = u.pn * 128 + wc * 32 + 8 * fq + 4 * N; const int nd0 = u.pn * 256 + wc * 32 + 8 * fq + 4 * N;
        const int slab = u.pm * 4 + ai * 2 + wr;
        f32x4 pg = (f32x4){0.f, 0.f, 0.f, 0.f}, pv = pg;
#pragma unroll
        for (int m = 0; m < 4; ++m) {
            const float r = rsqrtf(rs[ai][m] * (1.0f / 1024.0f) + EPS);
            const f32x4 ug = acc[ai][0][m][N] * r, uv = acc[ai][1][m][N] * r;
            float o[4];
#pragma unroll
            for (int e = 0; e < 4; ++e) {
                const float g1 = dppf<0x111>(dppf<0x121>(pg[e], pg[e]), ug[e]), g2 = dppf<0x112>(dppf<0x122>(pg[e], pg[e]), ug[e]);
                const float v1 = dppf<0x111>(dppf<0x121>(pv[e], pv[e]), uv[e]), v2 = dppf<0x112>(dppf<0x122>(pv[e], pv[e]), uv[e]);
                const float cg = w.bg[e] + w.wg[0][e] * g2 + w.wg[1][e] * g1 + w.wg[2][e] * ug[e];
                const float cv = w.bv[e] + w.wv[0][e] * v2 + w.wv[1][e] * v1 + w.wv[2][e] * uv[e];
                o[e] = siluf_(cg) * cv; }
            const size_t row = (size_t)(row0 + ai * 128 + m * 16);
            if (m > 0 || fr >= 2) { u32x2 ow; ow.x = cvt_pk_bf16(o[0], o[1]); ow.y = cvt_pk_bf16(o[2], o[3]); *(u32x2*)(act + row * D_FF + cu) = ow; }
            if ((m == 0 && fr < 2) || (m == 3 && fr >= 14)) { const int which = m == 0 ? fr : fr - 12;
                bf16_t* sp = side + ((size_t)slab * 4 + which) * 5632 + nd0;
                u32x2 a; a.x = cvt_pk_bf16(ug[0], ug[1]); a.y = cvt_pk_bf16(ug[2], ug[3]); *(u32x2*)sp = a;
                u32x2 b; b.x = cvt_pk_bf16(uv[0], uv[1]); b.y = cvt_pk_bf16(uv[2], uv[3]); *(u32x2*)(sp + 128) = b; }
            pg = ug; pv = uv;
        }
    }
    __device__ __forceinline__ void operator()(const f32x4 (&acc)[2][2][4][2], const Unit& u, int wr, int wc, int fr, int fq) const {
        const int row0 = u.pm * 256 + wr * 64 + fr; const int cu = u.pn * 128 + wc * 32 + 8 * fq;
        W8 w0, w1; loadw(w0, cu);
        float rs[2][4];
#pragma unroll
        for (int ai = 0; ai < 2; ++ai)
#pragma unroll
            for (int m = 0; m < 4; ++m) rs[ai][m] = rowss[row0 + ai * 128 + m * 16];
        half<0>(acc, w0, rs, 0, u, wr, wc, fr, fq);
        loadw(w1, cu + 4);
        half<0>(acc, w0, rs, 1, u, wr, wc, fr, fq);
        half<1>(acc, w1, rs, 0, u, wr, wc, fr, fq);
        half<1>(acc, w1, rs, 1, u, wr, wc, fr, fq);
    }
};
struct EpiBf16 {
    static constexpr bool PERM = true;
    bf16_t* O; int ldc;
    __device__ __forceinline__ void operator()(const f32x4 (&acc)[2][2][4][2], const Unit& u, int wr, int wc, int fr, int fq) const {
        const int row0 = u.pm * 256 + wr * 64 + fr, col0 = u.pn * 256 + wc * 32 + 8 * fq;
#pragma unroll
        for (int ai = 0; ai < 2; ++ai)
#pragma unroll
            for (int m = 0; m < 4; ++m) { bf16_t* rowp = O + (size_t)(row0 + ai * 128 + m * 16) * ldc + col0;
#pragma unroll
                for (int bj = 0; bj < 2; ++bj) { const f32x4 v0 = acc[ai][bj][m][0], v1 = acc[ai][bj][m][1];
                    u32x4 w; w.x = cvt_pk_bf16(v0[0], v0[1]); w.y = cvt_pk_bf16(v0[2], v0[3]); w.z = cvt_pk_bf16(v1[0], v1[1]); w.w = cvt_pk_bf16(v1[2], v1[3]);
                    *(u32x4*)(rowp + bj * 128) = w; } }
    }
};
template <class Epi> __device__ __forceinline__ void run_gemm(LAS unsigned char* lds, const bf16_t* A, int lda, const bf16_t* Bt, int M, int N, int K, const Epi& E) {
    pg8::Gemm g; g.A = A; g.Bt = Bt; g.M = M; g.N = N; g.K = K; g.lda = lda;
    pg8::StaticOrder S; S.init(M, N, (int)gridDim.x, obid());
    pg8::gemm_phase<Epi, pg8::StaticOrder>(lds, g, S, E);
}

__device__ __forceinline__ void wprep_tile(const float* __restrict__ src, int Nsrc, int K, bf16_t* __restrict__ dst, int tn, int tk, int mode, LAS float* tl, const float* __restrict__ kscale = nullptr) {
    const int tid = otid(); const int nd0 = tn * 64, k0 = tk * 64;
    { const int nn = tid & 63; const int nd = nd0 + nn; int ns = nd;
      if (mode == 1) { if (nd < 6144) ns = nd; else if (nd < N_IN_MAIN) ns = nd + 32; else if (nd < N_IN_MAIN + 32) ns = 6144 + (nd - N_IN_MAIN); else ns = -1; }
      if (mode == 2) { const int tile = nd >> 8, within = nd & 255; ns = within < 128 ? tile * 128 + within : D_FF + tile * 128 + (within - 128); }
#pragma unroll
      for (int it = 0; it < 8; ++it) { const int kk = it * 8 + (tid >> 6); tl[kk * 65 + nn] = ns >= 0 ? src[(size_t)(k0 + kk) * Nsrc + ns] : 0.f; } }
    __syncthreads();
    { const int kk = tid & 63; const float ksc = kscale ? kscale[k0 + kk] : 1.0f;
#pragma unroll
      for (int it = 0; it < 8; ++it) { const int nn = it * 8 + (tid >> 6); dst[(size_t)(nd0 + nn) * K + k0 + kk] = f2bf(tl[kk * 65 + nn] * ksc); } }
    __syncthreads();
}
__device__ __forceinline__ void phase_wprep(const Params& p, LAS unsigned char* lds) {
    LAS float* tl = (LAS float*)lds;
    constexpr int n0 = 204 * 16, n1 = n0 + 16 * 32, n2 = n1 + 16 * 8, n3 = n2 + 16 * 16, n4 = n3 + 88 * 16, n5 = n4 + 16 * 44;
    for (int t = obid(); t < n5; t += gridDim.x) {
        if (t < n0) wprep_tile(p.w_in, N_IN_SRC, 1024, (bf16_t*)(p.ws + WS_WIN), t / 16, t % 16, 1, tl);
        else if (t < n1) { const int q = t - n0; wprep_tile(p.w_ssd_proj, 1024, 2048, (bf16_t*)(p.ws + WS_WSP), q / 32, q % 32, 0, tl); }
        else if (t < n2) { const int q = t - n1; wprep_tile(p.w_attn_proj, 1024, 512, (bf16_t*)(p.ws + WS_WAP), q / 8, q % 8, 0, tl); }
        else if (t < n3) { const int q = t - n2; wprep_tile(p.w_out, 1024, 1024, (bf16_t*)(p.ws + WS_WOUT), q / 16, q % 16, 0, tl); }
        else if (t < n4) { const int q = t - n3; wprep_tile(p.w_up, 5632, 1024, (bf16_t*)(p.ws + WS_WUP), q / 16, q % 16, 2, tl, p.norm2_g); }
        else { const int q = t - n4; wprep_tile(p.w_down, 1024, 2816, (bf16_t*)(p.ws + WS_WDN), q / 44, q % 44, 0, tl); }
    }
}

__device__ __forceinline__ void phase_rms(const float* __restrict__ src, const float* __restrict__ g, bf16_t* __restrict__ dst, int T) {
    const int tid = otid(), w = tid >> 6, lane = tid & 63;
    f32x4 gv[4];
#pragma unroll
    for (int i = 0; i < 4; ++i) gv[i] = *(const f32x4*)(g + i * 256 + lane * 4);
    for (int row = obid() * 8 + w; row < T; row += gridDim.x * 8) {
        const float* rp = src + (size_t)row * 1024;
        f32x4 v[4]; float ss = 0.f;
#pragma unroll
        for (int i = 0; i < 4; ++i) { v[i] = *(const f32x4*)(rp + i * 256 + lane * 4); ss += v[i][0] * v[i][0] + v[i][1] * v[i][1] + v[i][2] * v[i][2] + v[i][3] * v[i][3]; }
#pragma unroll
        for (int o = 32; o >= 1; o >>= 1) ss += __shfl_xor(ss, o);
        const float rs = rsqrtf(ss * (1.0f / 1024.0f) + EPS);
        bf16_t* op = dst + (size_t)row * 1024;
#pragma unroll
        for (int i = 0; i < 4; ++i) { u32x2 o; o.x = cvt_pk_bf16(v[i][0] * rs * gv[i][0], v[i][1] * rs * gv[i][1]); o.y = cvt_pk_bf16(v[i][2] * rs * gv[i][2], v[i][3] * rs * gv[i][3]);
            *(u32x2*)(op + i * 256 + lane * 4) = o; }
    }
}

constexpr int SLD = 136;
constexpr int L_CM = 0, L_BM = 34816, L_BT = 69632, L_XT = 104448, L_SB = 121856, L_FA = 139264;
__device__ __forceinline__ f32x16 mma32_k(const LAS bf16_t* A, const LAS bf16_t* B, int ksteps, f32x16 acc, int lane) {
    const LAS bf16_t* ap = A + (lane & 31) * SLD + (lane >> 5) * 8; const LAS bf16_t* bp = B + (lane & 31) * SLD + (lane >> 5) * 8;
    for (int ks = 0; ks < ksteps; ks += 2) {
        const bf16x8 a0 = *(const LAS bf16x8*)(ap + ks * 16), a1 = *(const LAS bf16x8*)(ap + ks * 16 + 16);
        const bf16x8 b0 = *(const LAS bf16x8*)(bp + ks * 16), b1 = *(const LAS bf16x8*)(bp + ks * 16 + 16);
        acc = __builtin_amdgcn_mfma_f32_32x32x16_bf16(a0, b0, acc, 0, 0, 0);
        acc = __builtin_amdgcn_mfma_f32_32x32x16_bf16(a1, b1, acc, 0, 0, 0); }
    return acc;
}
__device__ __forceinline__ f32x16 mma32_k8(const LAS bf16_t* A, const LAS bf16_t* B, f32x16 acc, int lane) {
    const LAS bf16_t* ap = A + (lane & 31) * SLD + (lane >> 5) * 8; const LAS bf16_t* bp = B + (lane & 31) * SLD + (lane >> 5) * 8;
#pragma unroll
    for (int h = 0; h < 2; ++h) {
        bf16x8 a[4], b[4];
#pragma unroll
        for (int ks = 0; ks < 4; ++ks) { a[ks] = *(const LAS bf16x8*)(ap + (h * 4 + ks) * 16); b[ks] = *(const LAS bf16x8*)(bp + (h * 4 + ks) * 16); }
#pragma unroll
        for (int ks = 0; ks < 4; ++ks) acc = __builtin_amdgcn_mfma_f32_32x32x16_bf16(a[ks], b[ks], acc, 0, 0, 0);
    }
    return acc;
}
__device__ __forceinline__ void ssd_item(const Params& p, LAS unsigned char* lds, int bl, int head, int dry) {
    const int tid = otid(), w = tid >> 6, lane = tid & 63; const int T = p.T;
    bf16_t* proj = (bf16_t*)(p.ws + ws_proj(T)); const float* dtraw = (const float*)(p.ws + ws_dt(T));
    LAS bf16_t* CM = (LAS bf16_t*)(lds + L_CM); LAS bf16_t* BMm = (LAS bf16_t*)(lds + L_BM); LAS bf16_t* BT = (LAS bf16_t*)(lds + L_BT);
    LAS bf16_t* XT = (LAS bf16_t*)(lds + L_XT); LAS bf16_t* SB = (LAS bf16_t*)(lds + L_SB);
    LAS float* fs = (LAS float*)(lds + L_FA);
    const float Ah = -__expf(p.a_log[head]), Dh = p.d_skip[head], dtb = p.dt_bias[head];
    const int g = head >> 2; const size_t rowbase = (size_t)bl * SEQ;
    const int pt = w >> 2, nt = w & 3;
    const int rsub = 4 * (lane >> 5), cl = lane & 31;
    const bool cact = tid < 320; const int cq = tid % 80, rg = (tid / 80) & 3, rgc = tid < 320 ? tid / 80 : 3;
    int kind, n4, col, ch;
    if (cq < 16) { kind = 0; n4 = 4 * cq; col = COL_XBC + head * 64 + n4; ch = head * 64 + n4; }
    else if (cq < 48) { kind = 1; n4 = 4 * (cq - 16); col = COL_XBC + 2048 + g * 128 + n4; ch = 2048 + g * 128 + n4; }
    else { kind = 2; n4 = 4 * (cq - 48); col = COL_XBC + 3072 + g * 128 + n4; ch = 3072 + g * 128 + n4; }
    f32x4 cw0, cw1, cw2, cw3, cbv;
    cw0 = *(const f32x4*)(p.ssd_conv_w + ch); cw1 = *(const f32x4*)(p.ssd_conv_w + CONV_DIM + ch); cw2 = *(const f32x4*)(p.ssd_conv_w + 2 * CONV_DIM + ch); cw3 = *(const f32x4*)(p.ssd_conv_w + 3 * CONV_DIM + ch);
    cbv = *(const f32x4*)(p.ssd_conv_b + ch);
    u32x2 raw[35]; float dtn0 = 0.f, dtn1 = 0.f; u32x2 zr[4];
    const size_t pstep = cact ? (size_t)PLD : (size_t)0;
    const int ti_d = w >> 1, pc_d = w & 1;
#define SSD_ISSUE(c_) do { const int c__ = (c_); \
        { const float* dp = dtraw + (rowbase + (size_t)c__ * 128 + lane) * 32 + head; dtn0 = dp[0]; dtn1 = dp[64 * 32]; } \
        { const int sb__ = cact ? c__ * 128 + rgc * 32 - 3 : 0; const bf16_t* gp = proj + rowbase * PLD + (cact ? col : COL_XBC); \
            _Pragma("unroll") for (int i = 0; i < 3; ++i) { const int sq = sb__ + i; raw[i] = *(const u32x2*)(gp + (size_t)(sq < 0 ? 0 : sq) * PLD); } \
            const bf16_t* gp3 = gp + (size_t)(sb__ + 3) * PLD; \
            _Pragma("unroll") for (int i = 3; i < 35; ++i) raw[i] = *(const u32x2*)(gp3 + (size_t)(i - 3) * pstep); } } while (0)
#define SSD_SCAN(c_) do { const int par__ = (c_) & 1; LAS float* f__ = fs + par__ * 384; \
        float v0 = dtn0 + dtb, v1 = dtn1 + dtb; const float d0 = v0 > 20.f ? v0 : log1pf(__expf(v0)), d1 = v1 > 20.f ? v1 : log1pf(__expf(v1)); \
        float s0 = d0 * Ah, s1 = d1 * Ah; \
        _Pragma("unroll") for (int o = 1; o < 64; o <<= 1) { const float t0 = __shfl_up(s0, o), t1 = __shfl_up(s1, o); if (lane >= o) { s0 += t0; s1 += t1; } } \
        s1 += __shfl(s0, 63); const float cl__ = __shfl(s1, 63); \
        f__[lane] = s0; f__[64 + lane] = s1; f__[128 + lane] = d0; f__[192 + lane] = d1; f__[256 + lane] = __expf(cl__ - s0); f__[320 + lane] = __expf(cl__ - s1); } while (0)
    SSD_ISSUE(0);
    if (w == 3) SSD_SCAN(0);
    f32x16 accS;
#pragma unroll
    for (int i = 0; i < 16; ++i) accS[i] = 0.f;
    for (int c = 0; c < 32; ++c) {
        const size_t r0 = rowbase + (size_t)c * 128;
        LAS float* fcs = fs + (c & 1) * 384; LAS float* fdt = fcs + 128; LAS float* fwl = fcs + 256;
        __syncthreads();
#pragma unroll
        for (int r = 0; r < 16; ++r) { const int row = (r & 3) + 8 * (r >> 2) + rsub; SB[(pt * 32 + row) * SLD + nt * 32 + cl] = f2bf(accS[r]); }
        if (cact) {
            if (c == 0 && rg == 0) { raw[0] = (u32x2){0u, 0u}; raw[1] = (u32x2){0u, 0u}; raw[2] = (u32x2){0u, 0u}; }
#pragma unroll
            for (int seg = 0; seg < 4; ++seg) {
                float val[8][4];
#pragma unroll
                for (int j = 0; j < 8; ++j) { const int i = seg * 8 + j;
                    const u32x2 x0 = raw[i], x1 = raw[i + 1], x2 = raw[i + 2], x3 = raw[i + 3];
                    float v0 = cbv[0] + cw0[0] * bflo(x0.x) + cw1[0] * bflo(x1.x) + cw2[0] * bflo(x2.x) + cw3[0] * bflo(x3.x);
                    float v1 = cbv[1] + cw0[1] * bfhi(x0.x) + cw1[1] * bfhi(x1.x) + cw2[1] * bfhi(x2.x) + cw3[1] * bfhi(x3.x);
                    float v2 = cbv[2] + cw0[2] * bflo(x0.y) + cw1[2] * bflo(x1.y) + cw2[2] * bflo(x2.y) + cw3[2] * bflo(x3.y);
                    float v3 = cbv[3] + cw0[3] * bfhi(x0.y) + cw1[3] * bfhi(x1.y) + cw2[3] * bfhi(x2.y) + cw3[3] * bfhi(x3.y);
                    val[j][0] = siluf_(v0); val[j][1] = siluf_(v1); val[j][2] = siluf_(v2); val[j][3] = siluf_(v3); }
                const int lb = rg * 32 + seg * 8;
                if (kind != 0) { LAS bf16_t* rm = (kind == 1 ? BMm : CM) + lb * SLD + n4;
#pragma unroll
                    for (int j = 0; j < 8; ++j) { u32x2 o; o.x = cvt_pk_bf16(val[j][0], val[j][1]); o.y = cvt_pk_bf16(val[j][2], val[j][3]); *(LAS u32x2*)(rm + j * SLD) = o; } }
                if (kind != 2) { LAS float* sc = (kind == 0 ? fdt : fwl) + lb; LAS bf16_t* tp = (kind == 0 ? XT : BT) + n4 * SLD + lb;
                    float scl[8];
#pragma unroll
                    for (int j = 0; j < 8; ++j) scl[j] = sc[j];
#pragma unroll
                    for (int e = 0; e < 4; ++e) { u32x4 o; o.x = cvt_pk_bf16(val[0][e] * scl[0], val[1][e] * scl[1]); o.y = cvt_pk_bf16(val[2][e] * scl[2], val[3][e] * scl[3]);
                        o.z = cvt_pk_bf16(val[4][e] * scl[4], val[5][e] * scl[5]); o.w = cvt_pk_bf16(val[6][e] * scl[6], val[7][e] * scl[7]); *(LAS u32x4*)(tp + e * SLD) = o; } }
            }
        }
        { const bf16_t* zp = proj + (r0 + ti_d * 32 + cl) * PLD + COL_Z + head * 64 + pc_d * 32 + rsub;
#pragma unroll
          for (int g4 = 0; g4 < 4; ++g4) zr[g4] = *(const u32x2*)(zp + 8 * g4); }
        __builtin_amdgcn_sched_barrier(0);
        SSD_ISSUE(c + 1 < 32 ? c + 1 : 31);
        __syncthreads();
        f32x16 cb[2]; int ti[2], tj[2];
#pragma unroll
        for (int q = 0; q < 2; ++q) { const int id = w + 8 * q; ti[q] = id >> 2; tj[q] = id & 3;
#pragma unroll
            for (int i = 0; i < 16; ++i) cb[q][i] = 0.f;
            if (tj[q] <= ti[q]) cb[q] = mma32_k8(CM + ti[q] * 32 * SLD, BMm + tj[q] * 32 * SLD, cb[q], lane); }
        __syncthreads();
#pragma unroll
        for (int q = 0; q < 2; ++q) if (tj[q] <= ti[q]) {
            const int s = tj[q] * 32 + cl; const float css = fcs[s];
#pragma unroll
            for (int r = 0; r < 16; ++r) { const int l = ti[q] * 32 + (r & 3) + 8 * (r >> 2) + rsub;
                const float mv = (s <= l) ? cb[q][r] * __expf(fcs[l] - css) : 0.f; BMm[l * SLD + s] = f2bf(mv); } }
        if (w == 3 && c + 1 < 32) SSD_SCAN(c + 1);
        __syncthreads();
        { const int i = ti_d, pc = pc_d;
          f32x16 accd, acco;
#pragma unroll
          for (int r = 0; r < 16; ++r) { accd[r] = 0.f; acco[r] = 0.f; }
          accd = mma32_k(XT + pc * 32 * SLD, BMm + i * 32 * SLD, 2 * (i + 1), accd, lane);
          acco = mma32_k8(SB + pc * 32 * SLD, CM + i * 32 * SLD, acco, lane);
          const int l = i * 32 + cl; const float ecs = __expf(fcs[l]), dsc = Dh * __builtin_amdgcn_rcpf(fdt[l]);
          bf16_t* zp = proj + (r0 + l) * PLD + COL_Z + head * 64 + pc * 32 + rsub;
#pragma unroll
          for (int g4 = 0; g4 < 4; ++g4) { float y[4];
#pragma unroll
              for (int e = 0; e < 4; ++e) { const int pp = pc * 32 + 8 * g4 + rsub + e; y[e] = accd[g4 * 4 + e] + ecs * acco[g4 * 4 + e] + dsc * bf2f(XT[pp * SLD + l]); }
              const u32x2 z2 = zr[g4];
              y[0] *= siluf_(bflo(z2.x)); y[1] *= siluf_(bfhi(z2.x)); y[2] *= siluf_(bflo(z2.y)); y[3] *= siluf_(bfhi(z2.y));
              u32x2 o; o.x = cvt_pk_bf16(y[0], y[1]); o.y = cvt_pk_bf16(y[2], y[3]);
              if (!dry) *(u32x2*)(zp + 8 * g4) = o; } }
        { const float cd = __expf(fcs[127]);
#pragma unroll
          for (int r = 0; r < 16; ++r) accS[r] *= cd;
          accS = mma32_k8(XT + pt * 32 * SLD, BT + nt * 32 * SLD, accS, lane); }
    }
    __syncthreads();
#undef SSD_ISSUE
#undef SSD_SCAN
}

constexpr int KLD = 72, VLD = 392; constexpr int L_KS = 0, L_VT = 384 * KLD * 2;
struct AttnItem { size_t rowbase; int gi, h, r, nbk0, d, qcol; };
__device__ __forceinline__ AttnItem attn_decode(int a) {
    AttnItem I; I.h = a & 7; const int j = (a & 127) >> 3; const int gb = a >> 7; const int bl = gb / 3; I.gi = gb - bl * 3;
    const int lg = I.gi * 2; I.d = 1 << lg; I.r = j & (I.d - 1); I.nbk0 = (j >> lg) * 2; I.rowbase = (size_t)bl * SEQ; I.qcol = COL_Q + I.gi * 512 + I.h * 64; return I;
}
__device__ __forceinline__ void attn_load(const bf16_t* proj, const AttnItem& I, int tid, u32x4 (&kr)[6], u32x4 (&vr)[6], u32x4 (&qr)[2][2]) {
    const int piece = tid & 7, w = tid >> 6, lane = tid & 63;
#pragma unroll
    for (int it = 0; it < 6; ++it) { const int kk = it * 64 + (tid >> 3); const int km = I.nbk0 * 128 - 128 + kk;
        const size_t tok = I.rowbase + (size_t)(km < 0 ? 0 : km) * I.d + I.r;
        const u32x4 k4 = *(const u32x4*)(proj + tok * PLD + I.qcol + 1536 + piece * 8), v4 = *(const u32x4*)(proj + tok * PLD + I.qcol + 3072 + piece * 8);
        kr[it].x = km < 0 ? 0u : k4.x; kr[it].y = km < 0 ? 0u : k4.y; kr[it].z = km < 0 ? 0u : k4.z; kr[it].w = km < 0 ? 0u : k4.w;
        vr[it].x = km < 0 ? 0u : v4.x; vr[it].y = km < 0 ? 0u : v4.y; vr[it].z = km < 0 ? 0u : v4.z; vr[it].w = km < 0 ? 0u : v4.w; }
#pragma unroll
    for (int blk = 0; blk < 2; ++blk) { const int qq = 16 * w + (lane & 15); const size_t tokq = I.rowbase + (size_t)((I.nbk0 + blk) * 128 + qq) * I.d + I.r;
        qr[blk][0] = *(const u32x4*)(proj + tokq * PLD + I.qcol + 8 * (lane >> 4)); qr[blk][1] = *(const u32x4*)(proj + tokq * PLD + I.qcol + 32 + 8 * (lane >> 4)); }
}
__device__ __forceinline__ void attn_item(const Params& p, LAS unsigned char* lds, const AttnItem& I, const AttnItem& N, u32x4 (&kr)[6], u32x4 (&vr)[6], u32x4 (&qr)[2][2],
                                          const float (&gk)[8], const float (&gq)[2][8], int dry) {
    const int tid = otid(), w = tid >> 6, lane = tid & 63; const int T = p.T;
    bf16_t* proj = (bf16_t*)(p.ws + ws_proj(T)); float* lse = (float*)(p.ws + ws_lse(T));
    LAS bf16_t* KS = (LAS bf16_t*)(lds + L_KS); LAS bf16_t* VT = (LAS bf16_t*)(lds + L_VT);
    const int gi = I.gi, h = I.h, d = I.d, r = I.r; const size_t rowbase = I.rowbase; const int qcol = I.qcol;
    __syncthreads();
    { const int piece = tid & 7;
#pragma unroll
      for (int it = 0; it < 6; ++it) { const int kk = it * 64 + (tid >> 3);
          const u32x4 k4 = kr[it], v4 = vr[it];
          float kf[8]; kf[0] = bflo(k4.x); kf[1] = bfhi(k4.x); kf[2] = bflo(k4.y); kf[3] = bfhi(k4.y); kf[4] = bflo(k4.z); kf[5] = bfhi(k4.z); kf[6] = bflo(k4.w); kf[7] = bfhi(k4.w);
          float ss = 0.f;
#pragma unroll
          for (int e = 0; e < 8; ++e) ss += kf[e] * kf[e];
          ss += dppf<0xB1>(ss, ss); ss += dppf<0x4E>(ss, ss); ss += dppf<0x141>(ss, ss);
          const float rs = rsqrtf(ss * (1.0f / 64.0f) + EPS);
          u32x4 ko; ko.x = cvt_pk_bf16(kf[0] * rs * gk[0], kf[1] * rs * gk[1]); ko.y = cvt_pk_bf16(kf[2] * rs * gk[2], kf[3] * rs * gk[3]);
          ko.z = cvt_pk_bf16(kf[4] * rs * gk[4], kf[5] * rs * gk[5]); ko.w = cvt_pk_bf16(kf[6] * rs * gk[6], kf[7] * rs * gk[7]);
          *(LAS u32x4*)(KS + kk * KLD + piece * 8) = ko;
          LAS bf16_t* vp = VT + (piece * 8) * VLD + kk;
          vp[0] = (bf16_t)(v4.x & 0xffffu); vp[VLD] = (bf16_t)(v4.x >> 16); vp[2 * VLD] = (bf16_t)(v4.y & 0xffffu); vp[3 * VLD] = (bf16_t)(v4.y >> 16);
          vp[4 * VLD] = (bf16_t)(v4.z & 0xffffu); vp[5 * VLD] = (bf16_t)(v4.z >> 16); vp[6 * VLD] = (bf16_t)(v4.w & 0xffffu); vp[7 * VLD] = (bf16_t)(v4.w >> 16); } }
    const int fr = lane & 15, fq = lane >> 4;
    const int qq = 16 * w + fr;
    bf16x8 qf[2][2];
#pragma unroll
    for (int blk = 0; blk < 2; ++blk) { float qv[2][8]; float ss = 0.f;
#pragma unroll
      for (int ks = 0; ks < 2; ++ks) { const u32x4 q4 = qr[blk][ks]; qv[ks][0] = bflo(q4.x); qv[ks][1] = bfhi(q4.x); qv[ks][2] = bflo(q4.y); qv[ks][3] = bfhi(q4.y);
          qv[ks][4] = bflo(q4.z); qv[ks][5] = bfhi(q4.z); qv[ks][6] = bflo(q4.w); qv[ks][7] = bfhi(q4.w);
#pragma unroll
          for (int e = 0; e < 8; ++e) ss += qv[ks][e] * qv[ks][e]; }
      ss += __shfl_xor(ss, 16); ss += __shfl_xor(ss, 32);
      const float rs = rsqrtf(ss * (1.0f / 64.0f) + EPS) * 0.125f;
#pragma unroll
      for (int ks = 0; ks < 2; ++ks) { u32x4 o;
          o.x = cvt_pk_bf16(qv[ks][0] * rs * gq[ks][0], qv[ks][1] * rs * gq[ks][1]); o.y = cvt_pk_bf16(qv[ks][2] * rs * gq[ks][2], qv[ks][3] * rs * gq[ks][3]);
          o.z = cvt_pk_bf16(qv[ks][4] * rs * gq[ks][4], qv[ks][5] * rs * gq[ks][5]); o.w = cvt_pk_bf16(qv[ks][6] * rs * gq[ks][6], qv[ks][7] * rs * gq[ks][7]);
          qf[blk][ks] = __builtin_bit_cast(bf16x8, o); } }
    __syncthreads();
    attn_load(proj, N, tid, kr, vr, qr);
    const int ts = w < 6 ? w : 6;
#pragma unroll
    for (int blk = 0; blk < 2; ++blk) {
        const int nbk = I.nbk0 + blk; const size_t tokq = rowbase + (size_t)(nbk * 128 + qq) * d + r;
        f32x4 s[10]; float mx = -INFINITY;
#pragma unroll
        for (int tt = 0; tt < 10; ++tt) { const int kt = ts + tt; f32x4 a4 = (f32x4){0.f, 0.f, 0.f, 0.f};
#pragma unroll
            for (int ks = 0; ks < 2; ++ks) { const bf16x8 a = *(const LAS bf16x8*)(KS + ((blk * 8 + kt) * 16 + fr) * KLD + ks * 32 + 8 * fq); a4 = __builtin_amdgcn_mfma_f32_16x16x32_bf16(a, qf[blk][ks], a4, 0, 0, 0); }
#pragma unroll
            for (int i = 0; i < 4; ++i) { const int kk = kt * 16 + 4 * fq + i; const int dist = 128 + qq - kk; const int km = nbk * 128 - 128 + kk;
                const bool ok = (dist >= 0) && (dist <= 128) && (km >= 0); a4[i] = ok ? a4[i] : -INFINITY; mx = fmaxf(mx, a4[i]); }
            s[tt] = a4; }
        mx = fmaxf(mx, __shfl_xor(mx, 16)); mx = fmaxf(mx, __shfl_xor(mx, 32));
        float den = 0.f;
#pragma unroll
        for (int tt = 0; tt < 10; ++tt)
#pragma unroll
            for (int i = 0; i < 4; ++i) { const float e = __expf(s[tt][i] - mx); s[tt][i] = e; den += e; }
        den += __shfl_xor(den, 16); den += __shfl_xor(den, 32);
        f32x4 ao[4];
#pragma unroll
        for (int mt = 0; mt < 4; ++mt) ao[mt] = (f32x4){0.f, 0.f, 0.f, 0.f};
#pragma unroll
        for (int kp = 0; kp < 5; ++kp) {
            u32x4 pk; pk.x = cvt_pk_bf16(s[2 * kp][0], s[2 * kp][1]); pk.y = cvt_pk_bf16(s[2 * kp][2], s[2 * kp][3]); pk.z = cvt_pk_bf16(s[2 * kp + 1][0], s[2 * kp + 1][1]); pk.w = cvt_pk_bf16(s[2 * kp + 1][2], s[2 * kp + 1][3]);
            const bf16x8 pb = __builtin_bit_cast(bf16x8, pk);
#pragma unroll
            for (int mt = 0; mt < 4; ++mt) { const LAS bf16_t* vp = VT + (mt * 16 + fr) * VLD + blk * 128 + (ts + 2 * kp) * 16 + 4 * fq;
                const u32x2 lo = *(const LAS u32x2*)vp; const u32x2 hi = *(const LAS u32x2*)(vp + 16);
                u32x4 av; av.x = lo.x; av.y = lo.y; av.z = hi.x; av.w = hi.y;
                ao[mt] = __builtin_amdgcn_mfma_f32_16x16x32_bf16(__builtin_bit_cast(bf16x8, av), pb, ao[mt], 0, 0, 0); } }
        const float inv = __builtin_amdgcn_rcpf(den);
#pragma unroll
        for (int mt = 0; mt < 4; ++mt) { u32x2 o; o.x = cvt_pk_bf16(ao[mt][0] * inv, ao[mt][1] * inv); o.y = cvt_pk_bf16(ao[mt][2] * inv, ao[mt][3] * inv);
            if (!dry) *(u32x2*)(proj + tokq * PLD + qcol + mt * 16 + 4 * fq) = o; }
        if (fq == 0 && !dry) lse[((size_t)gi * T + tokq) * 8 + h] = mx + __logf(den);
    }
}

__device__ __forceinline__ void phase_mixer(const Params& p, LAS unsigned char* lds, int dry, int which) {
    const int nb = p.T / SEQ; const int nssd = nb * SSD_HEADS; const int nattn = nb * 3 * 8 * 16; const int G = (int)gridDim.x;
    int it = obid();
    for (; it < nssd; it += G) { if (which & 1) { const int x8 = it & 7, y8 = it >> 3; ssd_item(p, lds, y8 >> 2, 4 * x8 + (y8 & 3), dry); } }
    if ((which & 2) && it < nssd + nattn) {
        const bf16_t* proj = (const bf16_t*)(p.ws + ws_proj(p.T)); const int tid = otid();
        float gk[8], gq[2][8];
#pragma unroll
        for (int e = 0; e < 8; ++e) { gk[e] = p.k_norm_g[(tid & 7) * 8 + e]; gq[0][e] = p.q_norm_g[8 * ((tid & 63) >> 4) + e]; gq[1][e] = p.q_norm_g[32 + 8 * ((tid & 63) >> 4) + e]; }
        u32x4 kr[6], vr[6], qr[2][2];
        AttnItem I = attn_decode(it - nssd);
        attn_load(proj, I, tid, kr, vr, qr);
        for (; it < nssd + nattn; it += G) {
            const bool has_next = it + G < nssd + nattn;
            const AttnItem N = attn_decode(has_next ? it + G - nssd : it - nssd);
            attn_item(p, lds, I, N, kr, vr, qr, gk, gq, dry);
            I = N;
        }
    }
    __syncthreads();
}

__device__ __forceinline__ void phase_post(const Params& p) {
    const int T = p.T; bf16_t* proj = (bf16_t*)(p.ws + ws_proj(T)); const float* lse = (const float*)(p.ws + ws_lse(T));
    const size_t gtid = (size_t)obid() * 512 + otid(), gn = (size_t)gridDim.x * 512;
    for (size_t idx0 = gtid; idx0 < (size_t)T * 64; idx0 += 4 * gn) {
        u32x4 va[4], vb[4], vc[4]; float l0[4], l1[4], l2[4];
#pragma unroll
        for (int q = 0; q < 4; ++q) { const size_t idx = (idx0 + q * gn < (size_t)T * 64) ? idx0 + q * gn : idx0; const size_t t = idx >> 6; const int h = (int)(idx >> 3) & 7, piece = (int)idx & 7;
            l0[q] = lse[(t) * 8 + h]; l1[q] = lse[((size_t)T + t) * 8 + h]; l2[q] = lse[((size_t)2 * T + t) * 8 + h];
            const bf16_t* bp = proj + t * PLD + COL_Q + h * 64 + piece * 8; va[q] = *(const u32x4*)bp; vb[q] = *(const u32x4*)(bp + 512); vc[q] = *(const u32x4*)(bp + 1024); }
#pragma unroll
        for (int q = 0; q < 4; ++q) { const size_t idx = idx0 + q * gn; if (idx >= (size_t)T * 64) break; const size_t t = idx >> 6; const int h = (int)(idx >> 3) & 7, piece = (int)idx & 7;
            const float m = fmaxf(l0[q], fmaxf(l1[q], l2[q])); float e0 = __expf(l0[q] - m), e1 = __expf(l1[q] - m), e2 = __expf(l2[q] - m); const float inv = __builtin_amdgcn_rcpf(e0 + e1 + e2); e0 *= inv; e1 *= inv; e2 *= inv;
            const u32x4 a = va[q], b = vb[q], c = vc[q];
            u32x4 o;
            o.x = cvt_pk_bf16(e0 * bflo(a.x) + e1 * bflo(b.x) + e2 * bflo(c.x), e0 * bfhi(a.x) + e1 * bfhi(b.x) + e2 * bfhi(c.x));
            o.y = cvt_pk_bf16(e0 * bflo(a.y) + e1 * bflo(b.y) + e2 * bflo(c.y), e0 * bfhi(a.y) + e1 * bfhi(b.y) + e2 * bfhi(c.y));
            o.z = cvt_pk_bf16(e0 * bflo(a.z) + e1 * bflo(b.z) + e2 * bflo(c.z), e0 * bfhi(a.z) + e1 * bfhi(b.z) + e2 * bfhi(c.z));
            o.w = cvt_pk_bf16(e0 * bflo(a.w) + e1 * bflo(b.w) + e2 * bflo(c.w), e0 * bfhi(a.w) + e1 * bfhi(b.w) + e2 * bfhi(c.w));
            *(u32x4*)(proj + t * PLD + COL_Q + h * 64 + piece * 8) = o; }
    }
    { float* rowss = (float*)(p.ws + ws_dt(T)); for (size_t i = gtid; i < (size_t)T; i += gn) rowss[i] = 0.f; }
    const int l32 = otid() & 31;
    for (size_t hw0 = gtid >> 5; hw0 < (size_t)T * 8; hw0 += 4 * (gn >> 5)) {
        u32x4 av[4];
#pragma unroll
        for (int q = 0; q < 4; ++q) { const size_t hw = hw0 + q * (gn >> 5); av[q] = *(const u32x4*)(proj + (hw >> 3) * PLD + COL_Z + ((int)hw & 7) * 256 + l32 * 8); }
#pragma unroll
        for (int q = 0; q < 4; ++q) { const size_t hw = hw0 + q * (gn >> 5); const size_t t = hw >> 3; const int g = (int)hw & 7;
            const u32x4 a = av[q];
            float v[8]; v[0] = bflo(a.x); v[1] = bfhi(a.x); v[2] = bflo(a.y); v[3] = bfhi(a.y); v[4] = bflo(a.z); v[5] = bfhi(a.z); v[6] = bflo(a.w); v[7] = bfhi(a.w);
            float ss = 0.f;
#pragma unroll
            for (int e = 0; e < 8; ++e) ss += v[e] * v[e];
            ss += dppf<0xB1>(ss, ss); ss += dppf<0x4E>(ss, ss); ss += dppf<0x141>(ss, ss); ss += dppf<0x140>(ss, ss); ss += __shfl_xor(ss, 16);
            const float rs = rsqrtf(ss * (1.0f / 256.0f) + EPS);
            const float* gp = p.ssd_norm_g + g * 256 + l32 * 8;
            u32x4 o; o.x = cvt_pk_bf16(v[0] * rs * gp[0], v[1] * rs * gp[1]); o.y = cvt_pk_bf16(v[2] * rs * gp[2], v[3] * rs * gp[3]);
            o.z = cvt_pk_bf16(v[4] * rs * gp[4], v[5] * rs * gp[5]); o.w = cvt_pk_bf16(v[6] * rs * gp[6], v[7] * rs * gp[7]);
            *(u32x4*)(proj + t * PLD + COL_Z + g * 256 + l32 * 8) = o; }
    }
}

__device__ __forceinline__ void phase_fixup(const Params& p) {
    const int T = p.T; const bf16_t* side = (const bf16_t*)(p.ws + ws_proj(T) + (size_t)T * 18944); bf16_t* act = (bf16_t*)(p.ws + ws_proj(T) + (size_t)T * 11264);
    const size_t gtid = (size_t)obid() * 512 + otid(), gn = (size_t)gridDim.x * 512;
    for (size_t idx = gtid; idx < (size_t)(T / 64) * 352; idx += gn) {
        const size_t sl = idx / 352; const int cgp = (int)(idx % 352); const int c0 = cgp * 8; const int tile = c0 >> 7, within = c0 & 127; const int ndg = tile * 256 + within;
        const bool first = ((sl * 64) % SEQ) == 0; const size_t slp = first ? sl : sl - 1;
        const bf16_t* s0 = side + sl * 4 * 5632 + ndg; const bf16_t* sp = side + slp * 4 * 5632 + ndg;
        u32x4 g[4], v[4];
        g[0] = *(const u32x4*)(sp + 2 * 5632); v[0] = *(const u32x4*)(sp + 2 * 5632 + 128);
        g[1] = *(const u32x4*)(sp + 3 * 5632); v[1] = *(const u32x4*)(sp + 3 * 5632 + 128);
        g[2] = *(const u32x4*)(s0); v[2] = *(const u32x4*)(s0 + 128);
        g[3] = *(const u32x4*)(s0 + 5632); v[3] = *(const u32x4*)(s0 + 5632 + 128);
        if (first) { g[0] = (u32x4){0u, 0u, 0u, 0u}; g[1] = g[0]; v[0] = g[0]; v[1] = g[0]; }
        float wg[3][8], wv[3][8], bg[8], bv[8];
#pragma unroll
        for (int i = 0; i < 3; ++i)
#pragma unroll
            for (int e = 0; e < 8; ++e) { wg[i][e] = p.ffn_conv_w[i * 5632 + c0 + e]; wv[i][e] = p.ffn_conv_w[i * 5632 + D_FF + c0 + e]; }
#pragma unroll
        for (int e = 0; e < 8; ++e) { bg[e] = p.ffn_conv_b[c0 + e]; bv[e] = p.ffn_conv_b[D_FF + c0 + e]; }
#pragma unroll
        for (int j = 0; j < 2; ++j) {
            const u32x4 a2 = g[j], a1 = g[j + 1], a0 = g[j + 2], c2 = v[j], c1 = v[j + 1], c0v = v[j + 2];
            float o[8];
#define CG1(e, fa, fb) { const float ug_ = bg[e] + wg[0][e] * fa(a2.fb) + wg[1][e] * fa(a1.fb) + wg[2][e] * fa(a0.fb); const float uv_ = bv[e] + wv[0][e] * fa(c2.fb) + wv[1][e] * fa(c1.fb) + wv[2][e] * fa(c0v.fb); o[e] = siluf_(ug_) * uv_; }
            CG1(0, bflo, x) CG1(1, bfhi, x) CG1(2, bflo, y) CG1(3, bfhi, y) CG1(4, bflo, z) CG1(5, bfhi, z) CG1(6, bflo, w) CG1(7, bfhi, w)
#undef CG1
            u32x4 ow; ow.x = cvt_pk_bf16(o[0], o[1]); ow.y = cvt_pk_bf16(o[2], o[3]); ow.z = cvt_pk_bf16(o[4], o[5]); ow.w = cvt_pk_bf16(o[6], o[7]);
            *(u32x4*)(act + (sl * 64 + j) * D_FF + c0) = ow;
        }
    }
}

#define XB_TMO      128
#define XB_XCNT(j)  (256  + 64 * (j))
#define XB_XSUB(j)  (1280 + 64 * (j))
#define XB_XGEN(j)  (2304 + 64 * (j))
#define XB_TOP      3328
#define XB_TOPGEN   3392
#define XCD_BAR_WORDS 3456
#define XB_SPIN_CAP (1u << 22)
__device__ __forceinline__ unsigned xb_ld(unsigned* p)              { return __hip_atomic_load(p, __ATOMIC_RELAXED, __HIP_MEMORY_SCOPE_AGENT); }
__device__ __forceinline__ unsigned xb_add(unsigned* p, unsigned v) { return __hip_atomic_fetch_add(p, v, __ATOMIC_RELAXED, __HIP_MEMORY_SCOPE_AGENT); }
__device__ __forceinline__ unsigned xb_xcc_id() { return (unsigned)__builtin_amdgcn_s_getreg((3 << 11) | 20) & 0xFu; }
#define XB_SPIN(cond, bar) do { unsigned _sp = 0; while (cond) { __builtin_amdgcn_s_sleep(1); \
    if ((++_sp & 255u) == 0u) { if (xb_ld(&(bar)[XB_TMO])) break; if (_sp > XB_SPIN_CAP) { atomicAdd(&(bar)[XB_TMO], 1u); break; } } } } while (0)
struct XcdBarrier { unsigned* bar; unsigned x; volatile LAS unsigned* st; };
__device__ __forceinline__ XcdBarrier xcd_barrier_post(unsigned* bar, volatile LAS unsigned* st) {
    XcdBarrier b; b.bar = bar; b.x = xb_xcc_id(); b.st = st;
    if (threadIdx.x == 0) (void)xb_add(&bar[XB_XCNT(b.x)], 1u);
    return b;
}
__device__ __forceinline__ void xcd_barrier_complete(unsigned* bar, unsigned x, unsigned& nloc, unsigned& nx) {
    const unsigned G = gridDim.x * gridDim.y * gridDim.z;
    unsigned sum, cnt, mine, sp = 0u;
    for (;;) {
        sum = 0u; cnt = 0u; mine = 0u;
#pragma unroll
        for (unsigned j = 0; j < 16; ++j) { const unsigned c = xb_ld(&bar[XB_XCNT(j)]); sum += c; cnt += (c > 0u) ? 1u : 0u; mine = (j == x) ? c : mine; }
        if (sum == G) break;
        __builtin_amdgcn_s_sleep(1);
        if ((++sp & 255u) == 0u) { if (xb_ld(&bar[XB_TMO])) break; if (sp > XB_SPIN_CAP) { atomicAdd(&bar[XB_TMO], 1u); break; } }
    }
    nloc = mine > 0u ? mine : 1u; nx = cnt > 0u ? cnt : 1u;
}
__device__ __forceinline__ void xcd_barrier(const XcdBarrier& b) {
    asm volatile("s_waitcnt vmcnt(0)" ::: "memory");
    __syncthreads();
    if (threadIdx.x == 0) {
        unsigned* bar = b.bar;
        __builtin_amdgcn_s_waitcnt(0);
        unsigned nloc = b.st[0], nx = b.st[1];
        if (nloc == 0u) { xcd_barrier_complete(bar, b.x, nloc, nx); b.st[0] = nloc; b.st[1] = nx; }
        const unsigned old = xb_add(&bar[XB_XSUB(b.x)], 1u);
        const unsigned gen = old / nloc;
        if (old + 1u == (gen + 1u) * nloc) {
            __builtin_amdgcn_fence(__ATOMIC_RELEASE, "agent");
            asm volatile("s_waitcnt vmcnt(0)" ::: "memory");
            const unsigned og = xb_add(&bar[XB_TOP], 1u);
            const unsigned tg = og / nx;
            if (og + 1u == (tg + 1u) * nx) xb_add(&bar[XB_TOPGEN], 1u);
            else XB_SPIN(xb_ld(&bar[XB_TOPGEN]) == tg, bar);
            __builtin_amdgcn_fence(__ATOMIC_ACQUIRE, "agent");
            xb_add(&bar[XB_XGEN(b.x)], 1u);
            asm volatile("s_waitcnt vmcnt(0)" ::: "memory");
        } else {
            XB_SPIN(xb_ld(&bar[XB_XGEN(b.x)]) == gen, bar);
            __builtin_amdgcn_fence(__ATOMIC_ACQUIRE, "agent");
            asm volatile("s_waitcnt vmcnt(0)" ::: "memory");
        }
    }
    __syncthreads();
}

constexpr int PH_PER_CHUNK = 10;
__global__ void __launch_bounds__(512) fwd_megakernel(Params p_in) {
    extern __shared__ __attribute__((aligned(16))) unsigned char smem[];
    LAS unsigned char* lds = (LAS unsigned char*)smem;
    cg::grid_group grid = cg::this_grid();
    volatile LAS unsigned* xbst = (volatile LAS unsigned*)(lds + LDS_BYTES - 16);
    if (threadIdx.x == 0) { xbst[0] = 0u; xbst[1] = 0u; }
    __syncthreads();
    XcdBarrier xb = xcd_barrier_post((unsigned*)(p_in.ws + WS_BAR), xbst);
#define GRID_SYNC() do { if (p.nchunks < 0) grid.sync(); xcd_barrier(xb); } while (0)
    Params p = p_in;
    for (int ph = p.ph_lo; ph < p.ph_hi; ++ph) {
        { size_t z_ = 0; asm volatile("" : "+s"(p.T), "+s"(z_)); p.ws = p_in.ws + z_; }
        const int T = p.T;
        const int chunk = ph / PH_PER_CHUNK, k = ph % PH_PER_CHUNK;
        const size_t tok0 = (size_t)chunk * T;
        bf16_t* H = (bf16_t*)(p.ws + ws_h(T)); bf16_t* PROJ = (bf16_t*)(p.ws + ws_proj(T));
        bf16_t* U = PROJ; bf16_t* ACT = (bf16_t*)(p.ws + ws_proj(T) + (size_t)T * 11264); bf16_t* X1B = (bf16_t*)(p.ws + ws_proj(T) + (size_t)T * 16896);
        float* xout = p.out + tok0 * 1024; const float* xin = p.x + tok0 * 1024;
        for (int rep = ((p.pad0 >> k) & 1); rep >= 0; --rep) {
        if (rep) { size_t z_ = 0; asm volatile("" : "+s"(p.T), "+s"(z_)); p.ws = p_in.ws + z_; }
        switch (k) {
#ifndef PHASE_MASK
#define PHASE_MASK 1023
#endif
#define EN(k_) if (!((PHASE_MASK >> (k_)) & 1)) break;
        case 0: EN(0) if (chunk == 0) phase_wprep(p, lds); phase_rms(xin, p.norm1_g, H, T); break;
        case 1: EN(1) { EpiInproj E; E.O = PROJ; E.dt = (float*)(p.ws + ws_dt(T)); run_gemm(lds, H, 1024, (const bf16_t*)(p.ws + WS_WIN), T, N_IN_PAD, 1024, E); } break;
        case 2: EN(2) phase_mixer(p, lds, rep, rep ? p.pad1 : 3); break;
        case 3: EN(3) phase_post(p); break;
        case 4: EN(4) { EpiGate<0> E0; E0.O = H; E0.G = PROJ + COL_GS; run_gemm(lds, PROJ + COL_Z, PLD, (const bf16_t*)(p.ws + WS_WSP), T, 1024, 2048, E0);
                  EpiGate<1> E1; E1.O = H; E1.G = PROJ + COL_GA; run_gemm(lds, PROJ + COL_Q, PLD, (const bf16_t*)(p.ws + WS_WAP), T, 1024, 512, E1); } break;
        case 5: EN(5) { EpiOut E; E.dst = xout; E.src = xin; E.xb = X1B; E.rowss = (float*)(p.ws + ws_dt(T)); run_gemm(lds, H, 1024, (const bf16_t*)(p.ws + WS_WOUT), T, 1024, 1024, E); } break;
        case 6: break;
        case 7: EN(7) { EpiUpConv E; E.act = ACT; E.side = (bf16_t*)(p.ws + ws_proj(T) + (size_t)T * 18944); E.rowss = (const float*)(p.ws + ws_dt(T)); E.cw = p.ffn_conv_w; E.cbias = p.ffn_conv_b;
                  run_gemm(lds, X1B, 1024, (const bf16_t*)(p.ws + WS_WUP), T, 5632, 1024, E); } break;
        case 8: EN(8) phase_fixup(p); break;
        case 9: EN(9) { EpiDown E; E.dst = xout; E.xb = X1B; run_gemm(lds, ACT, D_FF, (const bf16_t*)(p.ws + WS_WDN), T, 1024, D_FF, E); } break;
        }
        if (rep) GRID_SYNC();
        }
#ifndef SYNC_REP
#define SYNC_REP 1
#endif
        if (ph + 1 < p.ph_hi && k != PH_PER_CHUNK - 1 && k != 6) for (int sr = 0; sr < SYNC_REP; ++sr) GRID_SYNC();
    }
}

#ifndef MK_PER_PHASE_LAUNCH
#define MK_PER_PHASE_LAUNCH 0
#endif
extern "C" void kernel_launch(void* const* d_in, const int* in_sizes, int n_in, void* d_out, int out_size, void* d_ws, size_t ws_size, hipStream_t stream) {
    static int grid_blocks = 0;
    if (!grid_blocks) {
        int dev = 0, cus = 0, per_cu = 0;
        hipGetDevice(&dev);
        hipDeviceGetAttribute(&cus, hipDeviceAttributeMultiprocessorCount, dev);
        hipFuncSetAttribute((const void*)fwd_megakernel, hipFuncAttributeMaxDynamicSharedMemorySize, LDS_BYTES);
        hipOccupancyMaxActiveBlocksPerMultiprocessor(&per_cu, (const void*)fwd_megakernel, 512, LDS_BYTES);
        if (per_cu < 1) { fprintf(stderr, "occupancy query says %d blocks per CU\n", per_cu); per_cu = 1; }
        grid_blocks = cus * 1;
        (void)hipGetLastError();
    }
    if (hipMemsetAsync((char*)d_ws + WS_BAR, 0, WS_BAR_BYTES, stream) != hipSuccess) fprintf(stderr, "memset of barrier words failed\n");
    Params p{};
    const float** pp = (const float**)&p;
    for (int i = 0; i < 19; ++i) pp[i] = (const float*)d_in[i];
    p.out = (float*)d_out; p.ws = (unsigned char*)d_ws;
    int nb = 8;
    while (nb > 1 && ws_total(nb * SEQ) > ws_size) nb >>= 1;
    p.T = nb * SEQ; p.nchunks = BATCH / nb;
#ifndef DUP_MASK
#define DUP_MASK 0
#endif
#ifndef DUP_WHICH
#define DUP_WHICH 3
#endif
    p.pad0 = DUP_MASK; p.pad1 = DUP_WHICH;
    const int nph = p.nchunks * PH_PER_CHUNK;
#if MK_PER_PHASE_LAUNCH
    for (int ph = 0; ph < nph; ++ph) { p.ph_lo = ph; p.ph_hi = ph + 1; hipLaunchKernelGGL(fwd_megakernel, dim3(grid_blocks), dim3(512), LDS_BYTES, stream, p); }
#else
    p.ph_lo = 0; p.ph_hi = nph;
    void* args[] = {&p};
    hipError_t e = hipLaunchCooperativeKernel((const void*)fwd_megakernel, dim3(grid_blocks), dim3(512), args, LDS_BYTES, stream);
    if (e != hipSuccess) fprintf(stderr, "cooperative launch failed: %s (grid %d)\n", hipGetErrorString(e), grid_blocks);
#endif
}
```

```cpp
#include <hip/hip_runtime.h>
#include <hip/hip_cooperative_groups.h>
#include <cstdio>
#include <cstdint>
namespace cg = cooperative_groups;

namespace pg8 {
#define PG8_LAS __attribute__((address_space(3)))
typedef unsigned short bf16_t;
typedef short bf16x8 __attribute__((ext_vector_type(8)));
typedef float f32x4 __attribute__((ext_vector_type(4)));
typedef float f32x16 __attribute__((ext_vector_type(16)));
typedef unsigned u32x4 __attribute__((ext_vector_type(4)));
typedef unsigned u32x2 __attribute__((ext_vector_type(2)));
constexpr int BM = 256, BK = 64, HALF = 128, HTB = HALF * BK * 2, STAGE_BYTES = 8 * HTB, NXCD = 8, WGM = 8;

__host__ __device__ __forceinline__ int lds_byte(int r, int c) { const int st = (r >> 4) * 2 + (c >> 5), rr = r & 15, cc = c & 31, ob = rr * 64 + cc * 2; return st * 1024 + (ob ^ (((ob >> 9) & 1) << 5)); }
__host__ __device__ __forceinline__ void stage_rc(int b, int& R, int& C) { const int st = b / 1024, sb = b % 1024, swz = sb ^ (((sb >> 9) & 1) << 5); R = (st >> 1) * 16 + swz / 64; C = (st & 1) * 32 + (swz % 64) / 2; }
__host__ __device__ __forceinline__ int perm32(int rho) { const int n = rho >> 4, i = rho & 15; return 8 * (i >> 2) + 4 * n + (i & 3); }

struct Unit { int pm, pn; };
struct Gemm { const bf16_t* A; const bf16_t* Bt; int M, N, K, lda; };

struct StaticOrder {
    int nM, nN, nwg, G, c;
    __host__ __device__ void init(int M, int N, int G_, int c_) { nM = M / BM; nN = N / BM; nwg = nM * nN; G = G_; c = c_; }
    __host__ __device__ bool next(int i, Unit& u) const {
        const long L = (long)i * G + c; if (L >= nwg) return false;
        int wgid = (int)L; { const int q = nwg / NXCD, r = nwg % NXCD, xcd = wgid % NXCD, off = wgid / NXCD; wgid = (xcd < r ? xcd * (q + 1) : r * (q + 1) + (xcd - r) * q) + off; }
        const int nig = WGM * nN, gid = wgid / nig, fm = gid * WGM, gsz = (nM - fm) < WGM ? (nM - fm) : WGM;
        u.pm = fm + ((wgid % nig) % gsz); u.pn = (wgid % nig) / gsz; return true;
    }
    __device__ __forceinline__ void a_ready(const Unit&) const {}
    __device__ __forceinline__ void done(const Unit&) const {}
};

__device__ __forceinline__ unsigned cvt_pk_bf16(float lo, float hi) { unsigned r; asm volatile("v_cvt_pk_bf16_f32 %0, %1, %2" : "=v"(r) : "v"(lo), "v"(hi)); return r; }

template <class Epi, class Sched>
__device__ __forceinline__ void gemm_phase(PG8_LAS unsigned char* lds, const Gemm g, const Sched& S, const Epi& E) {
    int tid_ = threadIdx.x; asm volatile("" : "+v"(tid_));
    const int tid = tid_, wid = __builtin_amdgcn_readfirstlane(tid >> 6), lane = tid & 63, wr = wid >> 2, wc = wid & 3, fr = lane & 15, fq = lane >> 4;
    const int K = g.K, nt = K / BK, lda = g.lda;
    unsigned voffA[2], voffB[2];
#pragma unroll
    for (int i = 0; i < 2; ++i) { int R, C; stage_rc(tid * 16 + i * 8192, R, C); const int Rb = Epi::PERM ? ((R & ~31) + perm32(R & 31)) : R;
        voffA[i] = (unsigned)(R * lda + C) * 2u; voffB[i] = (unsigned)(Rb * K + C) * 2u; }
    const size_t kstep = (size_t)(BK * 2);
    const size_t hstepA = (size_t)HALF * lda * 2, hstepB = (size_t)HALF * K * 2;
    const size_t tstepA = 2 * hstepA, tstepB = 2 * hstepB;
    const unsigned ldsw = (unsigned)wid * 1024u;
    const int aoff = lds_byte(wr * 64 + fr, fq * 8), boff = lds_byte(wc * 32 + fr, fq * 8);
#define PG8_SA(b, h) (((b) * 2 + (h)) * HTB)
#define PG8_SB(b, h) ((4 + (b) * 2 + (h)) * HTB)
#define PG8_STAGE(bufoff, gbase, voff) do { _Pragma("unroll") for (int _i = 0; _i < 2; ++_i) \
        __builtin_amdgcn_global_load_lds((const unsigned*)((const char*)(gbase) + (voff)[_i]), (PG8_LAS unsigned*)(lds + (bufoff) + ldsw + _i * 8192), 16, 0, 0); } while (0)
#define PG8_LDA(dst, b, h) do { _Pragma("unroll") for (int m = 0; m < 4; ++m) _Pragma("unroll") for (int k = 0; k < 2; ++k) dst[m][k] = *(const PG8_LAS bf16x8*)(lds + PG8_SA(b, h) + aoff + m * 2048 + k * 1024); } while (0)
#define PG8_LDB(dst, b, h) do { _Pragma("unroll") for (int n = 0; n < 2; ++n) _Pragma("unroll") for (int k = 0; k < 2; ++k) dst[n][k] = *(const PG8_LAS bf16x8*)(lds + PG8_SB(b, h) + boff + n * 2048 + k * 1024); } while (0)
#define PG8_MMA(ai, bj, At, Bt) do { __builtin_amdgcn_s_setprio(1); _Pragma("unroll") for (int m = 0; m < 4; ++m) _Pragma("unroll") for (int n = 0; n < 2; ++n) _Pragma("unroll") for (int k = 0; k < 2; ++k) \
        acc[ai][bj][m][n] = __builtin_amdgcn_mfma_f32_16x16x32_bf16(Bt[n][k], At[m][k], acc[ai][bj][m][n], 0, 0, 0); __builtin_amdgcn_s_setprio(0); } while (0)
#define PG8_WAIT_V(n) asm volatile("s_waitcnt vmcnt(" #n ")" ::: "memory")
#define PG8_WAIT_L(n) asm volatile("s_waitcnt lgkmcnt(" #n ")" ::: "memory")
#define PG8_BAR __builtin_amdgcn_s_barrier()
#define PG8_SCHED __builtin_amdgcn_sched_barrier(0)
    Unit cur, nxt; int ui = 0;
    if (!S.next(0, cur)) return;
    f32x4 acc[2][2][4][2];
#pragma unroll
    for (int a = 0; a < 2; ++a)
#pragma unroll
        for (int b = 0; b < 2; ++b)
#pragma unroll
            for (int m = 0; m < 4; ++m)
#pragma unroll
                for (int n = 0; n < 2; ++n) acc[a][b][m][n] = (f32x4){0.f, 0.f, 0.f, 0.f};
    bf16x8 At[4][2], B0[2][2], B1[2][2];
    const char* cA = (const char*)g.A + (size_t)cur.pm * tstepA; const char* cB = (const char*)g.Bt + (size_t)cur.pn * tstepB;
    S.a_ready(cur);
    PG8_STAGE(PG8_SB(0, 0), cB, voffB); PG8_STAGE(PG8_SA(0, 0), cA, voffA); PG8_STAGE(PG8_SB(0, 1), cB + hstepB, voffB); PG8_STAGE(PG8_SA(0, 1), cA + hstepA, voffA);
    if (wr == 1) PG8_BAR;
    PG8_WAIT_V(4); PG8_BAR;
    PG8_STAGE(PG8_SB(1, 0), cB + kstep, voffB); PG8_STAGE(PG8_SA(1, 0), cA + kstep, voffA); PG8_STAGE(PG8_SB(1, 1), cB + hstepB + kstep, voffB);
    PG8_WAIT_V(6); PG8_BAR;
    for (;;) {
        const bool has_next = S.next(ui + 1, nxt);
        const char* nA = has_next ? (const char*)g.A + (size_t)nxt.pm * tstepA : cA; const char* nB = has_next ? (const char*)g.Bt + (size_t)nxt.pn * tstepB : cB;
        for (int t = 0; t < nt; t += 2) {
            const bool last = (t == nt - 2);
            const char* a1 = cA + (size_t)(t + 1) * kstep;
            const char* a2 = last ? nA : cA + (size_t)(t + 2) * kstep; const char* b2 = last ? nB : cB + (size_t)(t + 2) * kstep;
            const char* a3 = a2 + kstep; const char* b3 = b2 + kstep;
            if (last && has_next) S.a_ready(nxt);
            PG8_LDB(B0, 0, 0); PG8_SCHED; PG8_LDA(At, 0, 0); PG8_STAGE(PG8_SA(1, 1), a1 + hstepA, voffA);
            PG8_WAIT_L(8); PG8_BAR; PG8_WAIT_L(0); PG8_MMA(0, 0, At, B0); PG8_BAR; PG8_SCHED;
            PG8_LDB(B1, 0, 1); PG8_STAGE(PG8_SB(0, 0), b2, voffB);
            PG8_BAR; PG8_WAIT_L(0); PG8_MMA(0, 1, At, B1); PG8_BAR;
            PG8_LDA(At, 0, 1); PG8_STAGE(PG8_SA(0, 0), a2, voffA);
            PG8_BAR; PG8_WAIT_L(0); PG8_MMA(1, 0, At, B0); PG8_BAR; PG8_SCHED;
            PG8_STAGE(PG8_SB(0, 1), b2 + hstepB, voffB);
            PG8_WAIT_V(6); PG8_BAR; PG8_MMA(1, 1, At, B1); PG8_BAR;
            PG8_LDB(B0, 1, 0); PG8_SCHED; PG8_LDA(At, 1, 0); PG8_STAGE(PG8_SA(0, 1), a2 + hstepA, voffA);
            PG8_WAIT_L(8); PG8_BAR; PG8_WAIT_L(0); PG8_MMA(0, 0, At, B0); PG8_BAR; PG8_SCHED;
            PG8_LDB(B1, 1, 1); PG8_STAGE(PG8_SB(1, 0), b3, voffB);
            PG8_BAR; PG8_WAIT_L(0); PG8_MMA(0, 1, At, B1); PG8_BAR;
            PG8_LDA(At, 1, 1); PG8_STAGE(PG8_SA(1, 0), a3, voffA);
            PG8_BAR; PG8_WAIT_L(0); PG8_MMA(1, 0, At, B0); PG8_BAR; PG8_SCHED;
            PG8_STAGE(PG8_SB(1, 1), b3 + hstepB, voffB);
            PG8_WAIT_V(6); PG8_BAR; PG8_MMA(1, 1, At, B1); PG8_BAR;
        }
        E(acc, cur, wr, wc, fr, fq); S.done(cur);
        if (!has_next) break;
#pragma unroll
        for (int a = 0; a < 2; ++a)
#pragma unroll
            for (int b = 0; b < 2; ++b)
#pragma unroll
                for (int m = 0; m < 4; ++m)
#pragma unroll
                    for (int n = 0; n < 2; ++n) acc[a][b][m][n] = (f32x4){0.f, 0.f, 0.f, 0.f};
        cur = nxt; cA = nA; cB = nB; ++ui;
    }
    PG8_WAIT_V(0);
    if (wr == 0) PG8_BAR;
    PG8_BAR;
#undef PG8_SA
#undef PG8_SB
#undef PG8_STAGE
#undef PG8_LDA
#undef PG8_LDB
#undef PG8_MMA
#undef PG8_WAIT_V
#undef PG8_WAIT_L
#undef PG8_BAR
#undef PG8_SCHED
}
}

using pg8::bf16_t; using pg8::bf16x8; using pg8::f32x4; using pg8::f32x16; using pg8::u32x4; using pg8::u32x2; using pg8::Unit; using pg8::cvt_pk_bf16;
#define LAS __attribute__((address_space(3)))

constexpr int D_MODEL = 1024, SEQ = 4096, BATCH = 16;
constexpr int D_INNER = 2048, SSD_HEADS = 32, D_STATE = 128, CONV_DIM = 4096;
constexpr int D_FF = 2816;
constexpr int N_IN_SRC = 12832;
constexpr int N_IN_MAIN = 12800;
constexpr int N_IN_PAD = 13056;
constexpr int PLD = N_IN_MAIN;
constexpr int COL_Z = 0, COL_XBC = 2048, COL_Q = 6144, COL_GS = 10752, COL_GA = 11776;
constexpr float EPS = 1e-6f;
constexpr int LDS_BYTES = 147456;

constexpr size_t WS_BAR = 0;
constexpr size_t WS_BAR_BYTES = 16384;
constexpr size_t WS_WIN = WS_BAR_BYTES;
constexpr size_t WS_WSP = WS_WIN + (size_t)N_IN_PAD * 1024 * 2;
constexpr size_t WS_WAP = WS_WSP + (size_t)1024 * 2048 * 2;
constexpr size_t WS_WOUT = WS_WAP + (size_t)1024 * 512 * 2;
constexpr size_t WS_WUP = WS_WOUT + (size_t)1024 * 1024 * 2;
constexpr size_t WS_WDN = WS_WUP + (size_t)5632 * 1024 * 2;
constexpr size_t WS_ACT0 = WS_WDN + (size_t)1024 * 2816 * 2;
__host__ __device__ constexpr size_t ws_h(int T) { return WS_ACT0; }
__host__ __device__ constexpr size_t ws_dt(int T) { return ws_h(T) + (size_t)T * 2048; }
__host__ __device__ constexpr size_t ws_lse(int T) { return ws_dt(T) + (size_t)T * 128; }
__host__ __device__ constexpr size_t ws_proj(int T) { return ws_lse(T) + (size_t)T * 96; }
__host__ __device__ constexpr size_t ws_total(int T) { return ws_proj(T) + (size_t)T * 25600; }

struct Params {
    const float* x; const float* norm1_g; const float* w_in; const float* ssd_conv_w; const float* ssd_conv_b;
    const float* dt_bias; const float* a_log; const float* d_skip; const float* ssd_norm_g; const float* w_ssd_proj;
    const float* q_norm_g; const float* k_norm_g; const float* w_attn_proj; const float* w_out; const float* norm2_g;
    const float* w_up; const float* ffn_conv_w; const float* ffn_conv_b; const float* w_down;
    float* out; unsigned char* ws;
    int T, nchunks, ph_lo, ph_hi, pad0, pad1;
};

__device__ __forceinline__ float bf2f(unsigned short b) { return __uint_as_float(((unsigned)b) << 16); }
__device__ __forceinline__ float bflo(unsigned u) { return __uint_as_float(u << 16); }
__device__ __forceinline__ float bfhi(unsigned u) { return __uint_as_float(u & 0xffff0000u); }
__device__ __forceinline__ unsigned short f2bf(float f) { return (unsigned short)(cvt_pk_bf16(f, 0.f) & 0xffffu); }
__device__ __forceinline__ int otid() { int t = threadIdx.x; asm volatile("" : "+v"(t)); return t; }
__device__ __forceinline__ int obid() { int t = blockIdx.x; asm volatile("" : "+s"(t)); return t; }
__device__ __forceinline__ float sigmoidf_(float v) { return __builtin_amdgcn_rcpf(1.0f + __expf(-v)); }
__device__ __forceinline__ float siluf_(float v) { return v * __builtin_amdgcn_rcpf(1.0f + __expf(-v)); }
template <int CTRL> __device__ __forceinline__ float dppf(float old, float src) {
    return __builtin_bit_cast(float, __builtin_amdgcn_update_dpp(__builtin_bit_cast(int, old), __builtin_bit_cast(int, src), CTRL, 0xF, 0xF, false));
}

struct EpiInproj {
    static constexpr bool PERM = true;
    bf16_t* O; float* dt;
    __device__ __forceinline__ void operator()(const f32x4 (&acc)[2][2][4][2], const Unit& u, int wr, int wc, int fr, int fq) const {
        const int row0 = u.pm * 256 + wr * 64 + fr;
        if (u.pn < 50) {
            const int col0 = u.pn * 256 + wc * 32 + 8 * fq;
#pragma unroll
            for (int ai = 0; ai < 2; ++ai)
#pragma unroll
                for (int m = 0; m < 4; ++m) { bf16_t* rowp = O + (size_t)(row0 + ai * 128 + m * 16) * PLD + col0;
#pragma unroll
                    for (int bj = 0; bj < 2; ++bj) { const f32x4 v0 = acc[ai][bj][m][0], v1 = acc[ai][bj][m][1];
                        u32x4 w; w.x = cvt_pk_bf16(v0[0], v0[1]); w.y = cvt_pk_bf16(v0[2], v0[3]); w.z = cvt_pk_bf16(v1[0], v1[1]); w.w = cvt_pk_bf16(v1[2], v1[3]);
                        *(u32x4*)(rowp + bj * 128) = w; } }
        } else if (wc == 0) {
#pragma unroll
            for (int ai = 0; ai < 2; ++ai)
#pragma unroll
                for (int m = 0; m < 4; ++m) { float* rp = dt + (size_t)(row0 + ai * 128 + m * 16) * 32 + 8 * fq;
                    *(f32x4*)(rp) = acc[ai][0][m][0]; *(f32x4*)(rp + 4) = acc[ai][0][m][1]; }
        }
    }
};
template <int MODE  > struct EpiGate {
    static constexpr bool PERM = true;
    bf16_t* O; const bf16_t* G;
    __device__ __forceinline__ void operator()(const f32x4 (&acc)[2][2][4][2], const Unit& u, int wr, int wc, int fr, int fq) const {
        const int row0 = u.pm * 256 + wr * 64 + fr, col0 = u.pn * 256 + wc * 32 + 8 * fq;
#pragma unroll
        for (int ai = 0; ai < 2; ++ai) {
            u32x4 gq[4][2];
#pragma unroll
            for (int m = 0; m < 4; ++m)
#pragma unroll
                for (int bj = 0; bj < 2; ++bj) gq[m][bj] = *(const u32x4*)(G + (size_t)(row0 + ai * 128 + m * 16) * PLD + col0 + bj * 128);
#pragma unroll
            for (int mp = 0; mp < 2; ++mp) {
                u32x4 oq[2][2];
                if (MODE == 1) {
#pragma unroll
                    for (int mm = 0; mm < 2; ++mm)
#pragma unroll
                        for (int bj = 0; bj < 2; ++bj) oq[mm][bj] = *(const u32x4*)(O + (size_t)(row0 + ai * 128 + (mp * 2 + mm) * 16) * 1024 + col0 + bj * 128); }
#pragma unroll
                for (int mm = 0; mm < 2; ++mm)
#pragma unroll
                    for (int bj = 0; bj < 2; ++bj) { const int m = mp * 2 + mm; const size_t row = (size_t)(row0 + ai * 128 + m * 16);
                        const f32x4 v0 = acc[ai][bj][m][0], v1 = acc[ai][bj][m][1]; const u32x4 g4 = gq[m][bj];
                        float r[8];
                        r[0] = v0[0] * sigmoidf_(bflo(g4.x)); r[1] = v0[1] * sigmoidf_(bfhi(g4.x)); r[2] = v0[2] * sigmoidf_(bflo(g4.y)); r[3] = v0[3] * sigmoidf_(bfhi(g4.y));
                        r[4] = v1[0] * sigmoidf_(bflo(g4.z)); r[5] = v1[1] * sigmoidf_(bfhi(g4.z)); r[6] = v1[2] * sigmoidf_(bflo(g4.w)); r[7] = v1[3] * sigmoidf_(bfhi(g4.w));
                        if (MODE == 1) { const u32x4 o = oq[mm][bj];
                            r[0] += bflo(o.x); r[1] += bfhi(o.x); r[2] += bflo(o.y); r[3] += bfhi(o.y); r[4] += bflo(o.z); r[5] += bfhi(o.z); r[6] += bflo(o.w); r[7] += bfhi(o.w); }
                        u32x4 w; w.x = cvt_pk_bf16(r[0], r[1]); w.y = cvt_pk_bf16(r[2], r[3]); w.z = cvt_pk_bf16(r[4], r[5]); w.w = cvt_pk_bf16(r[6], r[7]);
                        *(u32x4*)(O + row * 1024 + col0 + bj * 128) = w; }
            }
        }
    }
};
struct EpiRes {
    static constexpr bool PERM = false;
    float* dst; const float* src;
    __device__ __forceinline__ void operator()(const f32x4 (&acc)[2][2][4][2], const Unit& u, int wr, int wc, int fr, int fq) const {
        const int row0 = u.pm * 256 + wr * 64 + fr, col0 = u.pn * 256 + wc * 32 + 4 * fq;
#pragma unroll
        for (int ai = 0; ai < 2; ++ai)
#pragma unroll
            for (int mp = 0; mp < 2; ++mp) {
                f32x4 sv[2][2][2];
#pragma unroll
                for (int mm = 0; mm < 2; ++mm) { const size_t off = (size_t)(row0 + ai * 128 + (mp * 2 + mm) * 16) * 1024 + col0;
#pragma unroll
                    for (int bj = 0; bj < 2; ++bj)
#pragma unroll
                        for (int n = 0; n < 2; ++n) sv[mm][bj][n] = *(const f32x4*)(src + off + bj * 128 + n * 16); }
#pragma unroll
                for (int mm = 0; mm < 2; ++mm) { const int m = mp * 2 + mm; const size_t off = (size_t)(row0 + ai * 128 + m * 16) * 1024 + col0;
#pragma unroll
                    for (int bj = 0; bj < 2; ++bj)
#pragma unroll
                        for (int n = 0; n < 2; ++n) *(f32x4*)(dst + off + bj * 128 + n * 16) = sv[mm][bj][n] + acc[ai][bj][m][n]; }
            }
    }
};
struct EpiOut {
    static constexpr bool PERM = false;
    float* dst; const float* src; bf16_t* xb; float* rowss;
    __device__ __forceinline__ void operator()(const f32x4 (&acc)[2][2][4][2], const Unit& u, int wr, int wc, int fr, int fq) const {
        const int row0 = u.pm * 256 + wr * 64 + fr, col0 = u.pn * 256 + wc * 32 + 4 * fq;
#pragma unroll
        for (int ai = 0; ai < 2; ++ai)
#pragma unroll
            for (int mp = 0; mp < 2; ++mp) {
                f32x4 sv[2][2][2];
#pragma unroll
                for (int mm = 0; mm < 2; ++mm) { const size_t off = (size_t)(row0 + ai * 128 + (mp * 2 + mm) * 16) * 1024 + col0;
#pragma unroll
                    for (int bj = 0; bj < 2; ++bj)
#pragma unroll
                        for (int n = 0; n < 2; ++n) sv[mm][bj][n] = *(const f32x4*)(src + off + bj * 128 + n * 16); }
#pragma unroll
                for (int mm = 0; mm < 2; ++mm) { const int m = mp * 2 + mm; const int row = row0 + ai * 128 + m * 16; const size_t off = (size_t)row * 1024 + col0; float ss = 0.f;
#pragma unroll
                    for (int bj = 0; bj < 2; ++bj)
#pragma unroll
                        for (int n = 0; n < 2; ++n) { const f32x4 v = sv[mm][bj][n] + acc[ai][bj][m][n];
                            ss += v[0] * v[0] + v[1] * v[1] + v[2] * v[2] + v[3] * v[3];
                            u32x2 o; o.x = cvt_pk_bf16(v[0], v[1]); o.y = cvt_pk_bf16(v[2], v[3]); *(u32x2*)(xb + off + bj * 128 + n * 16) = o; }
                    ss += __shfl_xor(ss, 16); ss += __shfl_xor(ss, 32);
                    if (fq == 0) atomicAdd(rowss + row, ss); }
            }
    }
};
struct EpiDown {
    static constexpr bool PERM = false;
    float* dst; const bf16_t* xb;
    __device__ __forceinline__ void operator()(const f32x4 (&acc)[2][2][4][2], const Unit& u, int wr, int wc, int fr, int fq) const {
        const int row0 = u.pm * 256 + wr * 64 + fr, col0 = u.pn * 256 + wc * 32 + 4 * fq;
#pragma unroll
        for (int ai = 0; ai < 2; ++ai) {
            u32x2 sv[4][2][2];
#pragma unroll
            for (int m = 0; m < 4; ++m) { const size_t off = (size_t)(row0 + ai * 128 + m * 16) * 1024 + col0;
#pragma unroll
                for (int bj = 0; bj < 2; ++bj)
#pragma unroll
                    for (int n = 0; n < 2; ++n) sv[m][bj][n] = *(const u32x2*)(xb + off + bj * 128 + n * 16); }
#pragma unroll
            for (int m = 0; m < 4; ++m) { const size_t off = (size_t)(row0 + ai * 128 + m * 16) * 1024 + col0;
#pragma unroll
                for (int bj = 0; bj < 2; ++bj)
#pragma unroll
                    for (int n = 0; n < 2; ++n) { const u32x2 x2 = sv[m][bj][n]; const f32x4 a = acc[ai][bj][m][n];
                        f32x4 o; o[0] = bflo(x2.x) + a[0]; o[1] = bfhi(x2.x) + a[1]; o[2] = bflo(x2.y) + a[2]; o[3] = bfhi(x2.y) + a[3];
                        *(f32x4*)(dst + off + bj * 128 + n * 16) = o; } }
        }
    }
};
struct EpiUp {
    static constexpr bool PERM = true;
    bf16_t* O; const float* rowss;
    __device__ __forceinline__ void operator()(const f32x4 (&acc)[2][2][4][2], const Unit& u, int wr, int wc, int fr, int fq) const {
        const int row0 = u.pm * 256 + wr * 64 + fr, col0 = u.pn * 256 + wc * 32 + 8 * fq;
        float rs[2][4];
#pragma unroll
        for (int ai = 0; ai < 2; ++ai)
#pragma unroll
            for (int m = 0; m < 4; ++m) rs[ai][m] = rowss[row0 + ai * 128 + m * 16];
#pragma unroll
        for (int ai = 0; ai < 2; ++ai)
#pragma unroll
            for (int m = 0; m < 4; ++m) { bf16_t* rowp = O + (size_t)(row0 + ai * 128 + m * 16) * 5632 + col0; const float r = rsqrtf(rs[ai][m] * (1.0f / 1024.0f) + EPS);
#pragma unroll
                for (int bj = 0; bj < 2; ++bj) { const f32x4 v0 = acc[ai][bj][m][0] * r, v1 = acc[ai][bj][m][1] * r;
                    u32x4 w; w.x = cvt_pk_bf16(v0[0], v0[1]); w.y = cvt_pk_bf16(v0[2], v0[3]); w.z = cvt_pk_bf16(v1[0], v1[1]); w.w = cvt_pk_bf16(v1[2], v1[3]);
                    *(u32x4*)(rowp + bj * 128) = w; } }
    }
};
struct EpiUpConv {
    static constexpr bool PERM = true;
    bf16_t* act; bf16_t* side; const float* rowss; const float* cw; const float* cbias;
    struct W8 { f32x4 wg[3], wv[3], bg, bv; };
    __device__ __forceinline__ void loadw(W8& w, int c) const {
#pragma unroll
        for (int i = 0; i < 3; ++i) { w.wg[i] = *(const f32x4*)(cw + i * 5632 + c); w.wv[i] = *(const f32x4*)(cw + i * 5632 + D_FF + c); }
        w.bg = *(const f32x4*)(cbias + c); w.bv = *(const f32x4*)(cbias + D_FF + c);
    }
    template <int N> __device__ __forceinline__ void half(const f32x4 (&acc)[2][2][4][2], const W8& w, const float (&rs)[2][4], int ai, const Unit& u, int wr, int wc, int fr, int fq) const {
        const int row0 = u.pm * 256 + wr * 64 + fr; const int cu = u.pn * 128 + wc * 32 + 8 * fq + 4 * N; const int nd0 = u.pn * 256 + wc * 32 + 8 * fq + 4 * N;
        const int slab = u.pm * 4 + ai * 2 + wr;
        f32x4 pg = (f32x4){0.f, 0.f, 0.f, 0.f}, pv = pg;
#pragma unroll
        for (int m = 0; m < 4; ++m) {
            const float r = rsqrtf(rs[ai][m] * (1.0f / 1024.0f) + EPS);
            const f32x4 ug = acc[ai][0][m][N] * r, uv = acc[ai][1][m][N] * r;
            float o[4];
#pragma unroll
            for (int e = 0; e < 4; ++e) {
                const float g1 = dppf<0x111>(dppf<0x121>(pg[e], pg[e]), ug[e]), g2 = dppf<0x112>(dppf<0x122>(pg[e], pg[e]), ug[e]);
                const float v1 = dppf<0x111>(dppf<0x121>(pv[e], pv[e]), uv[e]), v2 = dppf<0x112>(dppf<0x122>(pv[e], pv[e]), uv[e]);
                const float cg = w.bg[e] + w.wg[0][e] * g2 + w.wg[1][e] * g1 + w.wg[2][e] * ug[e];
                const float cv = w.bv[e] + w.wv[0][e] * v2 + w.wv[1][e] * v1 + w.wv[2][e] * uv[e];
                o[e] = siluf_(cg) * cv; }
            const size_t row = (size_t)(row0 + ai * 128 + m * 16);
            if (m > 0 || fr >= 2) { u32x2 ow; ow.x = cvt_pk_bf16(o[0], o[1]); ow.y = cvt_pk_bf16(o[2], o[3]); *(u32x2*)(act + row * D_FF + cu) = ow; }
            if ((m == 0 && fr < 2) || (m == 3 && fr >= 14)) { const int which = m == 0 ? fr : fr - 12;
                bf16_t* sp = side + ((size_t)slab * 4 + which) * 5632 + nd0;
                u32x2 a; a.x = cvt_pk_bf16(ug[0], ug[1]); a.y = cvt_pk_bf16(ug[2], ug[3]); *(u32x2*)sp = a;
                u32x2 b; b.x = cvt_pk_bf16(uv[0], uv[1]); b.y = cvt_pk_bf16(uv[2], uv[3]); *(u32x2*)(sp + 128) = b; }
            pg = ug; pv = uv;
        }
    }
    __device__ __forceinline__ void operator()(const f32x4 (&acc)[2][2][4][2], const Unit& u, int wr, int wc, int fr, int fq) const {
        const int row0 = u.pm * 256 + wr * 64 + fr; const int cu = u.pn * 128 + wc * 32 + 8 * fq;
        W8 w0, w1; loadw(w0, cu);
        float rs[2][4];
#pragma unroll
        for (int ai = 0; ai < 2; ++ai)
#pragma unroll
            for (int m = 0; m < 4; ++m) rs[ai][m] = rowss[row0 + ai * 128 + m * 16];
        half<0>(acc, w0, rs, 0, u, wr, wc, fr, fq);
        loadw(w1, cu + 4);
        half<0>(acc, w0, rs, 1, u, wr, wc, fr, fq);
        half<1>(acc, w1, rs, 0, u, wr, wc, fr, fq);
        half<1>(acc, w1, rs, 1, u, wr, wc, fr, fq);
    }
};
struct EpiBf16 {
    static constexpr bool PERM = true;
    bf16_t* O; int ldc;
    __device__ __forceinline__ void operator()(const f32x4 (&acc)[2][2][4][2], const Unit& u, int wr, int wc, int fr, int fq) const {
        const int row0 = u.pm * 256 + wr * 64 + fr, col0 = u.pn * 256 + wc * 32 + 8 * fq;
#pragma unroll
        for (int ai = 0; ai < 2; ++ai)
#pragma unroll
            for (int m = 0; m < 4; ++m) { bf16_t* rowp = O + (size_t)(row0 + ai * 128 + m * 16) * ldc + col0;
#pragma unroll
                for (int bj = 0; bj < 2; ++bj) { const f32x4 v0 = acc[ai][bj][m][0], v1 = acc[ai][bj][m][1];
                    u32x4 w; w.x = cvt_pk_bf16(v0[0], v0[1]); w.y = cvt_pk_bf16(v0[2], v0[3]); w.z = cvt_pk_bf16(v1[0], v1[1]); w.w = cvt_pk_bf16(v1[2], v1[3]);
                    *(u32x4*)(rowp + bj * 128) = w; } }
    }
};
template <class Epi> __device__ __forceinline__ void run_gemm(LAS unsigned char* lds, const bf16_t* A, int lda, const bf16_t* Bt, int M, int N, int K, const Epi& E) {
    pg8::Gemm g; g.A = A; g.Bt = Bt; g.M = M; g.N = N; g.K = K; g.lda = lda;
    pg8::StaticOrder S; S.init(M, N, (int)gridDim.x, obid());
    pg8::gemm_phase<Epi, pg8::StaticOrder>(lds, g, S, E);
}

__device__ __forceinline__ void wprep_tile(const float* __restrict__ src, int Nsrc, int K, bf16_t* __restrict__ dst, int tn, int tk, int mode, LAS float* tl, const float* __restrict__ kscale = nullptr) {
    const int tid = otid(); const int nd0 = tn * 64, k0 = tk * 64;
    { const int nn = tid & 63; const int nd = nd0 + nn; int ns = nd;
      if (mode == 1) { if (nd < 6144) ns = nd; else if (nd < N_IN_MAIN) ns = nd + 32; else if (nd < N_IN_MAIN + 32) ns = 6144 + (nd - N_IN_MAIN); else ns = -1; }
      if (mode == 2) { const int tile = nd >> 8, within = nd & 255; ns = within < 128 ? tile * 128 + within : D_FF + tile * 128 + (within - 128); }
#pragma unroll
      for (int it = 0; it < 8; ++it) { const int kk = it * 8 + (tid >> 6); tl[kk * 65 + nn] = ns >= 0 ? src[(size_t)(k0 + kk) * Nsrc + ns] : 0.f; } }
    __syncthreads();
    { const int kk = tid & 63; const float ksc = kscale ? kscale[k0 + kk] : 1.0f;
#pragma unroll
      for (int it = 0; it < 8; ++it) { const int nn = it * 8 + (tid >> 6); dst[(size_t)(nd0 + nn) * K + k0 + kk] = f2bf(tl[kk * 65 + nn] * ksc); } }
    __syncthreads();
}
__device__ __forceinline__ void phase_wprep(const Params& p, LAS unsigned char* lds) {
    LAS float* tl = (LAS float*)lds;
    constexpr int n0 = 204 * 16, n1 = n0 + 16 * 32, n2 = n1 + 16 * 8, n3 = n2 + 16 * 16, n4 = n3 + 88 * 16, n5 = n4 + 16 * 44;
    for (int t = obid(); t < n5; t += gridDim.x) {
        if (t < n0) wprep_tile(p.w_in, N_IN_SRC, 1024, (bf16_t*)(p.ws + WS_WIN), t / 16, t % 16, 1, tl);
        else if (t < n1) { const int q = t - n0; wprep_tile(p.w_ssd_proj, 1024, 2048, (bf16_t*)(p.ws + WS_WSP), q / 32, q % 32, 0, tl); }
        else if (t < n2) { const int q = t - n1; wprep_tile(p.w_attn_proj, 1024, 512, (bf16_t*)(p.ws + WS_WAP), q / 8, q % 8, 0, tl); }
        else if (t < n3) { const int q = t - n2; wprep_tile(p.w_out, 1024, 1024, (bf16_t*)(p.ws + WS_WOUT), q / 16, q % 16, 0, tl); }
        else if (t < n4) { const int q = t - n3; wprep_tile(p.w_up, 5632, 1024, (bf16_t*)(p.ws + WS_WUP), q / 16, q % 16, 2, tl, p.norm2_g); }
        else { const int q = t - n4; wprep_tile(p.w_down, 1024, 2816, (bf16_t*)(p.ws + WS_WDN), q / 44, q % 44, 0, tl); }
    }
}

__device__ __forceinline__ void phase_rms(const float* __restrict__ src, const float* __restrict__ g, bf16_t* __restrict__ dst, int T) {
    const int tid = otid(), w = tid >> 6, lane = tid & 63;
    f32x4 gv[4];
#pragma unroll
    for (int i = 0; i < 4; ++i) gv[i] = *(const f32x4*)(g + i * 256 + lane * 4);
    for (int row = obid() * 8 + w; row < T; row += gridDim.x * 8) {
        const float* rp = src + (size_t)row * 1024;
        f32x4 v[4]; float ss = 0.f;
#pragma unroll
        for (int i = 0; i < 4; ++i) { v[i] = *(const f32x4*)(rp + i * 256 + lane * 4); ss += v[i][0] * v[i][0] + v[i][1] * v[i][1] + v[i][2] * v[i][2] + v[i][3] * v[i][3]; }
#pragma unroll
        for (int o = 32; o >= 1; o >>= 1) ss += __shfl_xor(ss, o);
        const float rs = rsqrtf(ss * (1.0f / 1024.0f) + EPS);
        bf16_t* op = dst + (size_t)row * 1024;
#pragma unroll
        for (int i = 0; i < 4; ++i) { u32x2 o; o.x = cvt_pk_bf16(v[i][0] * rs * gv[i][0], v[i][1] * rs * gv[i][1]); o.y = cvt_pk_bf16(v[i][2] * rs * gv[i][2], v[i][3] * rs * gv[i][3]);
            *(u32x2*)(op + i * 256 + lane * 4) = o; }
    }
}

constexpr int SLD = 136;
constexpr int L_CM = 0, L_BM = 34816, L_BT = 69632, L_XT = 104448, L_SB = 121856, L_FA = 139264;
__device__ __forceinline__ f32x16 mma32_k(const LAS bf16_t* A, const LAS bf16_t* B, int ksteps, f32x16 acc, int lane) {
    const LAS bf16_t* ap = A + (lane & 31) * SLD + (lane >> 5) * 8; const LAS bf16_t* bp = B + (lane & 31) * SLD + (lane >> 5) * 8;
    for (int ks = 0; ks < ksteps; ks += 2) {
        const bf16x8 a0 = *(const LAS bf16x8*)(ap + ks * 16), a1 = *(const LAS bf16x8*)(ap + ks * 16 + 16);
        const bf16x8 b0 = *(const LAS bf16x8*)(bp + ks * 16), b1 = *(const LAS bf16x8*)(bp + ks * 16 + 16);
        acc = __builtin_amdgcn_mfma_f32_32x32x16_bf16(a0, b0, acc, 0, 0, 0);
        acc = __builtin_amdgcn_mfma_f32_32x32x16_bf16(a1, b1, acc, 0, 0, 0); }
    return acc;
}
__device__ __forceinline__ f32x16 mma32_k8(const LAS bf16_t* A, const LAS bf16_t* B, f32x16 acc, int lane) {
    const LAS bf16_t* ap = A + (lane & 31) * SLD + (lane >> 5) * 8; const LAS bf16_t* bp = B + (lane & 31) * SLD + (lane >> 5) * 8;
#pragma unroll
    for (int h = 0; h < 2; ++h) {
        bf16x8 a[4], b[4];
#pragma unroll
        for (int ks = 0; ks < 4; ++ks) { a[ks] = *(const LAS bf16x8*)(ap + (h * 4 + ks) * 16); b[ks] = *(const LAS bf16x8*)(bp + (h * 4 + ks) * 16); }
#pragma unroll
        for (int ks = 0; ks < 4; ++ks) acc = __builtin_amdgcn_mfma_f32_32x32x16_bf16(a[ks], b[ks], acc, 0, 0, 0);
    }
    return acc;
}
__device__ __forceinline__ void ssd_item(const Params& p, LAS unsigned char* lds, int bl, int head, int dry) {
    const int tid = otid(), w = tid >> 6, lane = tid & 63; const int T = p.T;
    bf16_t* proj = (bf16_t*)(p.ws + ws_proj(T)); const float* dtraw = (const float*)(p.ws + ws_dt(T));
    LAS bf16_t* CM = (LAS bf16_t*)(lds + L_CM); LAS bf16_t* BMm = (LAS bf16_t*)(lds + L_BM); LAS bf16_t* BT = (LAS bf16_t*)(lds + L_BT);
    LAS bf16_t* XT = (LAS bf16_t*)(lds + L_XT); LAS bf16_t* SB = (LAS bf16_t*)(lds + L_SB);
    LAS float* fs = (LAS float*)(lds + L_FA);
    const float Ah = -__expf(p.a_log[head]), Dh = p.d_skip[head], dtb = p.dt_bias[head];
    const int g = head >> 2; const size_t rowbase = (size_t)bl * SEQ;
    const int pt = w >> 2, nt = w & 3;
    const int rsub = 4 * (lane >> 5), cl = lane & 31;
    const bool cact = tid < 320; const int cq = tid % 80, rg = (tid / 80) & 3, rgc = tid < 320 ? tid / 80 : 3;
    int kind, n4, col, ch;
    if (cq < 16) { kind = 0; n4 = 4 * cq; col = COL_XBC + head * 64 + n4; ch = head * 64 + n4; }
    else if (cq < 48) { kind = 1; n4 = 4 * (cq - 16); col = COL_XBC + 2048 + g * 128 + n4; ch = 2048 + g * 128 + n4; }
    else { kind = 2; n4 = 4 * (cq - 48); col = COL_XBC + 3072 + g * 128 + n4; ch = 3072 + g * 128 + n4; }
    f32x4 cw0, cw1, cw2, cw3, cbv;
    cw0 = *(const f32x4*)(p.ssd_conv_w + ch); cw1 = *(const f32x4*)(p.ssd_conv_w + CONV_DIM + ch); cw2 = *(const f32x4*)(p.ssd_conv_w + 2 * CONV_DIM + ch); cw3 = *(const f32x4*)(p.ssd_conv_w + 3 * CONV_DIM + ch);
    cbv = *(const f32x4*)(p.ssd_conv_b + ch);
    u32x2 raw[35]; float dtn0 = 0.f, dtn1 = 0.f; u32x2 zr[4];
    const size_t pstep = cact ? (size_t)PLD : (size_t)0;
    const int ti_d = w >> 1, pc_d = w & 1;
#define SSD_ISSUE_DT(c_) do { const int c__ = (c_); const float* dp = dtraw + (rowbase + (size_t)c__ * 128 + lane) * 32 + head; dtn0 = dp[0]; dtn1 = dp[64 * 32]; } while (0)
#define SSD_ISSUE_RAW(c_) do { const int c__ = (c_); \
        { const int sb__ = cact ? c__ * 128 + rgc * 32 - 3 : 0; const bf16_t* gp = proj + rowbase * PLD + (cact ? col : COL_XBC); \
            _Pragma("unroll") for (int i = 0; i < 3; ++i) { const int sq = sb__ + i; raw[i] = *(const u32x2*)(gp + (size_t)(sq < 0 ? 0 : sq) * PLD); } \
            const bf16_t* gp3 = gp + (size_t)(sb__ + 3) * PLD; \
            _Pragma("unroll") for (int i = 3; i < 35; ++i) raw[i] = *(const u32x2*)(gp3 + (size_t)(i - 3) * pstep); } } while (0)
#define SSD_SCAN(c_) do { const int par__ = (c_) & 1; LAS float* f__ = fs + par__ * 384; \
        float v0 = dtn0 + dtb, v1 = dtn1 + dtb; const float d0 = v0 > 20.f ? v0 : log1pf(__expf(v0)), d1 = v1 > 20.f ? v1 : log1pf(__expf(v1)); \
        float s0 = d0 * Ah, s1 = d1 * Ah; \
        _Pragma("unroll") for (int o = 1; o < 64; o <<= 1) { const float t0 = __shfl_up(s0, o), t1 = __shfl_up(s1, o); if (lane >= o) { s0 += t0; s1 += t1; } } \
        s1 += __shfl(s0, 63); const float cl__ = __shfl(s1, 63); \
        f__[lane] = s0; f__[64 + lane] = s1; f__[128 + lane] = d0; f__[192 + lane] = d1; f__[256 + lane] = __expf(cl__ - s0); f__[320 + lane] = __expf(cl__ - s1); } while (0)
    SSD_ISSUE_DT(0); SSD_ISSUE_RAW(0);
    if (w == 3) SSD_SCAN(0);
    f32x16 accS;
#pragma unroll
    for (int i = 0; i < 16; ++i) accS[i] = 0.f;
    for (int c = 0; c < 32; ++c) {
        const size_t r0 = rowbase + (size_t)c * 128;
        LAS float* fcs = fs + (c & 1) * 384; LAS float* fdt = fcs + 128; LAS float* fwl = fcs + 256;
        __syncthreads();
#pragma unroll
        for (int r = 0; r < 16; ++r) { const int row = (r & 3) + 8 * (r >> 2) + rsub; SB[(pt * 32 + row) * SLD + nt * 32 + cl] = f2bf(accS[r]); }
        { const bf16_t* zp = proj + (r0 + ti_d * 32 + cl) * PLD + COL_Z + head * 64 + pc_d * 32 + rsub;
#pragma unroll
          for (int g4 = 0; g4 < 4; ++g4) zr[g4] = *(const u32x2*)(zp + 8 * g4); }
        SSD_ISSUE_DT(c + 1 < 32 ? c + 1 : 31);
        __builtin_amdgcn_sched_barrier(0);
        if (cact) {
            if (c == 0 && rg == 0) { raw[0] = (u32x2){0u, 0u}; raw[1] = (u32x2){0u, 0u}; raw[2] = (u32x2){0u, 0u}; }
#pragma unroll
            for (int seg = 0; seg < 4; ++seg) {
                float val[8][4];
#pragma unroll
                for (int j = 0; j < 8; ++j) { const int i = seg * 8 + j;
                    const u32x2 x0 = raw[i], x1 = raw[i + 1], x2 = raw[i + 2], x3 = raw[i + 3];
                    float v0 = cbv[0] + cw0[0] * bflo(x0.x) + cw1[0] * bflo(x1.x) + cw2[0] * bflo(x2.x) + cw3[0] * bflo(x3.x);
                    float v1 = cbv[1] + cw0[1] * bfhi(x0.x) + cw1[1] * bfhi(x1.x) + cw2[1] * bfhi(x2.x) + cw3[1] * bfhi(x3.x);
                    float v2 = cbv[2] + cw0[2] * bflo(x0.y) + cw1[2] * bflo(x1.y) + cw2[2] * bflo(x2.y) + cw3[2] * bflo(x3.y);
                    float v3 = cbv[3] + cw0[3] * bfhi(x0.y) + cw1[3] * bfhi(x1.y) + cw2[3] * bfhi(x2.y) + cw3[3] * bfhi(x3.y);
                    val[j][0] = siluf_(v0); val[j][1] = siluf_(v1); val[j][2] = siluf_(v2); val[j][3] = siluf_(v3); }
                const int lb = rg * 32 + seg * 8;
                if (kind != 0) { LAS bf16_t* rm = (kind == 1 ? BMm : CM) + lb * SLD + n4;
#pragma unroll
                    for (int j = 0; j < 8; ++j) { u32x2 o; o.x = cvt_pk_bf16(val[j][0], val[j][1]); o.y = cvt_pk_bf16(val[j][2], val[j][3]); *(LAS u32x2*)(rm + j * SLD) = o; } }
                if (kind != 2) { LAS float* sc = (kind == 0 ? fdt : fwl) + lb; LAS bf16_t* tp = (kind == 0 ? XT : BT) + n4 * SLD + lb;
                    float scl[8];
#pragma unroll
                    for (int j = 0; j < 8; ++j) scl[j] = sc[j];
#pragma unroll
                    for (int e = 0; e < 4; ++e) { u32x4 o; o.x = cvt_pk_bf16(val[0][e] * scl[0], val[1][e] * scl[1]); o.y = cvt_pk_bf16(val[2][e] * scl[2], val[3][e] * scl[3]);
                        o.z = cvt_pk_bf16(val[4][e] * scl[4], val[5][e] * scl[5]); o.w = cvt_pk_bf16(val[6][e] * scl[6], val[7][e] * scl[7]); *(LAS u32x4*)(tp + e * SLD) = o; } }
            }
        }
        SSD_ISSUE_RAW(c + 1 < 32 ? c + 1 : 31);
        __syncthreads();
        f32x16 cb[2]; int ti[2], tj[2];
#pragma unroll
        for (int q = 0; q < 2; ++q) { const int id = w + 8 * q; ti[q] = id >> 2; tj[q] = id & 3;
#pragma unroll
            for (int i = 0; i < 16; ++i) cb[q][i] = 0.f;
            if (tj[q] <= ti[q]) cb[q] = mma32_k8(CM + ti[q] * 32 * SLD, BMm + tj[q] * 32 * SLD, cb[q], lane); }
        __syncthreads();
#pragma unroll
        for (int q = 0; q < 2; ++q) if (tj[q] <= ti[q]) {
            const int s = tj[q] * 32 + cl; const float css = fcs[s];
#pragma unroll
            for (int r = 0; r < 16; ++r) { const int l = ti[q] * 32 + (r & 3) + 8 * (r >> 2) + rsub;
                const float mv = (s <= l) ? cb[q][r] * __expf(fcs[l] - css) : 0.f; BMm[l * SLD + s] = f2bf(mv); } }
        if (w == 3 && c + 1 < 32) SSD_SCAN(c + 1);
        __syncthreads();
        { const int i = ti_d, pc = pc_d;
          f32x16 accd, acco;
#pragma unroll
          for (int r = 0; r < 16; ++r) { accd[r] = 0.f; acco[r] = 0.f; }
          accd = mma32_k(XT + pc * 32 * SLD, BMm + i * 32 * SLD, 2 * (i + 1), accd, lane);
          acco = mma32_k8(SB + pc * 32 * SLD, CM + i * 32 * SLD, acco, lane);
          const int l = i * 32 + cl; const float ecs = __expf(fcs[l]), dsc = Dh * __builtin_amdgcn_rcpf(fdt[l]);
          bf16_t* zp = proj + (r0 + l) * PLD + COL_Z + head * 64 + pc * 32 + rsub;
#pragma unroll
          for (int g4 = 0; g4 < 4; ++g4) { float y[4];
#pragma unroll
              for (int e = 0; e < 4; ++e) { const int pp = pc * 32 + 8 * g4 + rsub + e; y[e] = accd[g4 * 4 + e] + ecs * acco[g4 * 4 + e] + dsc * bf2f(XT[pp * SLD + l]); }
              const u32x2 z2 = zr[g4];
              y[0] *= siluf_(bflo(z2.x)); y[1] *= siluf_(bfhi(z2.x)); y[2] *= siluf_(bflo(z2.y)); y[3] *= siluf_(bfhi(z2.y));
              u32x2 o; o.x = cvt_pk_bf16(y[0], y[1]); o.y = cvt_pk_bf16(y[2], y[3]);
              if (!dry) *(u32x2*)(zp + 8 * g4) = o; } }
        { const float cd = __expf(fcs[127]);
#pragma unroll
          for (int r = 0; r < 16; ++r) accS[r] *= cd;
          accS = mma32_k8(XT + pt * 32 * SLD, BT + nt * 32 * SLD, accS, lane); }
    }
    __syncthreads();
#undef SSD_ISSUE_DT
#undef SSD_ISSUE_RAW
#undef SSD_SCAN
}

constexpr int KLD = 72, VLD = 392; constexpr int L_KS = 0, L_VT = 384 * KLD * 2;
struct AttnItem { size_t rowbase; int gi, h, r, nbk0, d, qcol; };
__device__ __forceinline__ AttnItem attn_decode(int a) {
    AttnItem I; I.h = a & 7; const int j = (a & 127) >> 3; const int gb = a >> 7; const int bl = gb / 3; I.gi = gb - bl * 3;
    const int lg = I.gi * 2; I.d = 1 << lg; I.r = j & (I.d - 1); I.nbk0 = (j >> lg) * 2; I.rowbase = (size_t)bl * SEQ; I.qcol = COL_Q + I.gi * 512 + I.h * 64; return I;
}
__device__ __forceinline__ void attn_load(const bf16_t* proj, const AttnItem& I, int tid, u32x4 (&kr)[6], u32x4 (&vr)[6], u32x4 (&qr)[2][2]) {
    const int piece = tid & 7, w = tid >> 6, lane = tid & 63;
#pragma unroll
    for (int it = 0; it < 6; ++it) { const int kk = it * 64 + (tid >> 3); const int km = I.nbk0 * 128 - 128 + kk;
        const size_t tok = I.rowbase + (size_t)(km < 0 ? 0 : km) * I.d + I.r;
        const u32x4 k4 = *(const u32x4*)(proj + tok * PLD + I.qcol + 1536 + piece * 8), v4 = *(const u32x4*)(proj + tok * PLD + I.qcol + 3072 + piece * 8);
        kr[it].x = km < 0 ? 0u : k4.x; kr[it].y = km < 0 ? 0u : k4.y; kr[it].z = km < 0 ? 0u : k4.z; kr[it].w = km < 0 ? 0u : k4.w;
        vr[it].x = km < 0 ? 0u : v4.x; vr[it].y = km < 0 ? 0u : v4.y; vr[it].z = km < 0 ? 0u : v4.z; vr[it].w = km < 0 ? 0u : v4.w; }
#pragma unroll
    for (int blk = 0; blk < 2; ++blk) { const int qq = 16 * w + (lane & 15); const size_t tokq = I.rowbase + (size_t)((I.nbk0 + blk) * 128 + qq) * I.d + I.r;
        qr[blk][0] = *(const u32x4*)(proj + tokq * PLD + I.qcol + 8 * (lane >> 4)); qr[blk][1] = *(const u32x4*)(proj + tokq * PLD + I.qcol + 32 + 8 * (lane >> 4)); }
}
__device__ __forceinline__ void attn_item(const Params& p, LAS unsigned char* lds, const AttnItem& I, const AttnItem& N, u32x4 (&kr)[6], u32x4 (&vr)[6], u32x4 (&qr)[2][2],
                                          const float (&gk)[8], const float (&gq)[2][8], int dry) {
    const int tid = otid(), w = tid >> 6, lane = tid & 63; const int T = p.T;
    bf16_t* proj = (bf16_t*)(p.ws + ws_proj(T)); float* lse = (float*)(p.ws + ws_lse(T));
    LAS bf16_t* KS = (LAS bf16_t*)(lds + L_KS); LAS bf16_t* VT = (LAS bf16_t*)(lds + L_VT);
    const int gi = I.gi, h = I.h, d = I.d, r = I.r; const size_t rowbase = I.rowbase; const int qcol = I.qcol;
    __syncthreads();
    { const int piece = tid & 7;
#pragma unroll
      for (int it = 0; it < 6; ++it) { const int kk = it * 64 + (tid >> 3);
          const u32x4 k4 = kr[it], v4 = vr[it];
          float kf[8]; kf[0] = bflo(k4.x); kf[1] = bfhi(k4.x); kf[2] = bflo(k4.y); kf[3] = bfhi(k4.y); kf[4] = bflo(k4.z); kf[5] = bfhi(k4.z); kf[6] = bflo(k4.w); kf[7] = bfhi(k4.w);
          float ss = 0.f;
#pragma unroll
          for (int e = 0; e < 8; ++e) ss += kf[e] * kf[e];
          ss += dppf<0xB1>(ss, ss); ss += dppf<0x4E>(ss, ss); ss += dppf<0x141>(ss, ss);
          const float rs = rsqrtf(ss * (1.0f / 64.0f) + EPS);
          u32x4 ko; ko.x = cvt_pk_bf16(kf[0] * rs * gk[0], kf[1] * rs * gk[1]); ko.y = cvt_pk_bf16(kf[2] * rs * gk[2], kf[3] * rs * gk[3]);
          ko.z = cvt_pk_bf16(kf[4] * rs * gk[4], kf[5] * rs * gk[5]); ko.w = cvt_pk_bf16(kf[6] * rs * gk[6], kf[7] * rs * gk[7]);
          *(LAS u32x4*)(KS + kk * KLD + piece * 8) = ko;
          LAS bf16_t* vp = VT + (piece * 8) * VLD + kk;
          vp[0] = (bf16_t)(v4.x & 0xffffu); vp[VLD] = (bf16_t)(v4.x >> 16); vp[2 * VLD] = (bf16_t)(v4.y & 0xffffu); vp[3 * VLD] = (bf16_t)(v4.y >> 16);
          vp[4 * VLD] = (bf16_t)(v4.z & 0xffffu); vp[5 * VLD] = (bf16_t)(v4.z >> 16); vp[6 * VLD] = (bf16_t)(v4.w & 0xffffu); vp[7 * VLD] = (bf16_t)(v4.w >> 16); } }
    const int fr = lane & 15, fq = lane >> 4;
    const int qq = 16 * w + fr;
    bf16x8 qf[2][2];
#pragma unroll
    for (int blk = 0; blk < 2; ++blk) { float qv[2][8]; float ss = 0.f;
#pragma unroll
      for (int ks = 0; ks < 2; ++ks) { const u32x4 q4 = qr[blk][ks]; qv[ks][0] = bflo(q4.x); qv[ks][1] = bfhi(q4.x); qv[ks][2] = bflo(q4.y); qv[ks][3] = bfhi(q4.y);
          qv[ks][4] = bflo(q4.z); qv[ks][5] = bfhi(q4.z); qv[ks][6] = bflo(q4.w); qv[ks][7] = bfhi(q4.w);
#pragma unroll
          for (int e = 0; e < 8; ++e) ss += qv[ks][e] * qv[ks][e]; }
      ss += __shfl_xor(ss, 16); ss += __shfl_xor(ss, 32);
      const float rs = rsqrtf(ss * (1.0f / 64.0f) + EPS) * 0.125f;
#pragma unroll
      for (int ks = 0; ks < 2; ++ks) { u32x4 o;
          o.x = cvt_pk_bf16(qv[ks][0] * rs * gq[ks][0], qv[ks][1] * rs * gq[ks][1]); o.y = cvt_pk_bf16(qv[ks][2] * rs * gq[ks][2], qv[ks][3] * rs * gq[ks][3]);
          o.z = cvt_pk_bf16(qv[ks][4] * rs * gq[ks][4], qv[ks][5] * rs * gq[ks][5]); o.w = cvt_pk_bf16(qv[ks][6] * rs * gq[ks][6], qv[ks][7] * rs * gq[ks][7]);
          qf[blk][ks] = __builtin_bit_cast(bf16x8, o); } }
    __syncthreads();
    attn_load(proj, N, tid, kr, vr, qr);
    const int ts = w < 6 ? w : 6;
#pragma unroll
    for (int blk = 0; blk < 2; ++blk) {
        const int nbk = I.nbk0 + blk; const size_t tokq = rowbase + (size_t)(nbk * 128 + qq) * d + r;
        f32x4 s[10]; float mx = -INFINITY;
#pragma unroll
        for (int tt = 0; tt < 10; ++tt) { const int kt = ts + tt; f32x4 a4 = (f32x4){0.f, 0.f, 0.f, 0.f};
#pragma unroll
            for (int ks = 0; ks < 2; ++ks) { const bf16x8 a = *(const LAS bf16x8*)(KS + ((blk * 8 + kt) * 16 + fr) * KLD + ks * 32 + 8 * fq); a4 = __builtin_amdgcn_mfma_f32_16x16x32_bf16(a, qf[blk][ks], a4, 0, 0, 0); }
#pragma unroll
            for (int i = 0; i < 4; ++i) { const int kk = kt * 16 + 4 * fq + i; const int dist = 128 + qq - kk; const int km = nbk * 128 - 128 + kk;
                const bool ok = (dist >= 0) && (dist <= 128) && (km >= 0); a4[i] = ok ? a4[i] : -INFINITY; mx = fmaxf(mx, a4[i]); }
            s[tt] = a4; }
        mx = fmaxf(mx, __shfl_xor(mx, 16)); mx = fmaxf(mx, __shfl_xor(mx, 32));
        float den = 0.f;
#pragma unroll
        for (int tt = 0; tt < 10; ++tt)
#pragma unroll
            for (int i = 0; i < 4; ++i) { const float e = __expf(s[tt][i] - mx); s[tt][i] = e; den += e; }
        den += __shfl_xor(den, 16); den += __shfl_xor(den, 32);
        f32x4 ao[4];
#pragma unroll
        for (int mt = 0; mt < 4; ++mt) ao[mt] = (f32x4){0.f, 0.f, 0.f, 0.f};
#pragma unroll
        for (int kp = 0; kp < 5; ++kp) {
            u32x4 pk; pk.x = cvt_pk_bf16(s[2 * kp][0], s[2 * kp][1]); pk.y = cvt_pk_bf16(s[2 * kp][2], s[2 * kp][3]); pk.z = cvt_pk_bf16(s[2 * kp + 1][0], s[2 * kp + 1][1]); pk.w = cvt_pk_bf16(s[2 * kp + 1][2], s[2 * kp + 1][3]);
            const bf16x8 pb = __builtin_bit_cast(bf16x8, pk);
#pragma unroll
            for (int mt = 0; mt < 4; ++mt) { const LAS bf16_t* vp = VT + (mt * 16 + fr) * VLD + blk * 128 + (ts + 2 * kp) * 16 + 4 * fq;
                const u32x2 lo = *(const LAS u32x2*)vp; const u32x2 hi = *(const LAS u32x2*)(vp + 16);
                u32x4 av; av.x = lo.x; av.y = lo.y; av.z = hi.x; av.w = hi.y;
                ao[mt] = __builtin_amdgcn_mfma_f32_16x16x32_bf16(__builtin_bit_cast(bf16x8, av), pb, ao[mt], 0, 0, 0); } }
        const float inv = __builtin_amdgcn_rcpf(den);
#pragma unroll
        for (int mt = 0; mt < 4; ++mt) { u32x2 o; o.x = cvt_pk_bf16(ao[mt][0] * inv, ao[mt][1] * inv); o.y = cvt_pk_bf16(ao[mt][2] * inv, ao[mt][3] * inv);
            if (!dry) *(u32x2*)(proj + tokq * PLD + qcol + mt * 16 + 4 * fq) = o; }
        if (fq == 0 && !dry) lse[((size_t)gi * T + tokq) * 8 + h] = mx + __logf(den);
    }
}

__device__ __forceinline__ void phase_mixer(const Params& p, LAS unsigned char* lds, int dry, int which) {
    const int nb = p.T / SEQ; const int nssd = nb * SSD_HEADS; const int nattn = nb * 3 * 8 * 16; const int G = (int)gridDim.x;
    int it = obid();
    for (; it < nssd; it += G) { if (which & 1) { const int x8 = it & 7, y8 = it >> 3; ssd_item(p, lds, y8 >> 2, 4 * x8 + (y8 & 3), dry); } }
    if ((which & 2) && it < nssd + nattn) {
        const bf16_t* proj = (const bf16_t*)(p.ws + ws_proj(p.T)); const int tid = otid();
        float gk[8], gq[2][8];
#pragma unroll
        for (int e = 0; e < 8; ++e) { gk[e] = p.k_norm_g[(tid & 7) * 8 + e]; gq[0][e] = p.q_norm_g[8 * ((tid & 63) >> 4) + e]; gq[1][e] = p.q_norm_g[32 + 8 * ((tid & 63) >> 4) + e]; }
        u32x4 kr[6], vr[6], qr[2][2];
        AttnItem I = attn_decode(it - nssd);
        attn_load(proj, I, tid, kr, vr, qr);
        for (; it < nssd + nattn; it += G) {
            const bool has_next = it + G < nssd + nattn;
            const AttnItem N = attn_decode(has_next ? it + G - nssd : it - nssd);
            attn_item(p, lds, I, N, kr, vr, qr, gk, gq, dry);
            I = N;
        }
    }
    __syncthreads();
}

__device__ __forceinline__ void phase_post(const Params& p) {
    const int T = p.T; bf16_t* proj = (bf16_t*)(p.ws + ws_proj(T)); const float* lse = (const float*)(p.ws + ws_lse(T));
    const size_t gtid = (size_t)obid() * 512 + otid(), gn = (size_t)gridDim.x * 512;
    for (size_t idx0 = gtid; idx0 < (size_t)T * 64; idx0 += 4 * gn) {
        u32x4 va[4], vb[4], vc[4]; float l0[4], l1[4], l2[4];
#pragma unroll
        for (int q = 0; q < 4; ++q) { const size_t idx = (idx0 + q * gn < (size_t)T * 64) ? idx0 + q * gn : idx0; const size_t t = idx >> 6; const int h = (int)(idx >> 3) & 7, piece = (int)idx & 7;
            l0[q] = lse[(t) * 8 + h]; l1[q] = lse[((size_t)T + t) * 8 + h]; l2[q] = lse[((size_t)2 * T + t) * 8 + h];
            const bf16_t* bp = proj + t * PLD + COL_Q + h * 64 + piece * 8; va[q] = *(const u32x4*)bp; vb[q] = *(const u32x4*)(bp + 512); vc[q] = *(const u32x4*)(bp + 1024); }
#pragma unroll
        for (int q = 0; q < 4; ++q) { const size_t idx = idx0 + q * gn; if (idx >= (size_t)T * 64) break; const size_t t = idx >> 6; const int h = (int)(idx >> 3) & 7, piece = (int)idx & 7;
            const float m = fmaxf(l0[q], fmaxf(l1[q], l2[q])); float e0 = __expf(l0[q] - m), e1 = __expf(l1[q] - m), e2 = __expf(l2[q] - m); const float inv = __builtin_amdgcn_rcpf(e0 + e1 + e2); e0 *= inv; e1 *= inv; e2 *= inv;
            const u32x4 a = va[q], b = vb[q], c = vc[q];
            u32x4 o;
            o.x = cvt_pk_bf16(e0 * bflo(a.x) + e1 * bflo(b.x) + e2 * bflo(c.x), e0 * bfhi(a.x) + e1 * bfhi(b.x) + e2 * bfhi(c.x));
            o.y = cvt_pk_bf16(e0 * bflo(a.y) + e1 * bflo(b.y) + e2 * bflo(c.y), e0 * bfhi(a.y) + e1 * bfhi(b.y) + e2 * bfhi(c.y));
            o.z = cvt_pk_bf16(e0 * bflo(a.z) + e1 * bflo(b.z) + e2 * bflo(c.z), e0 * bfhi(a.z) + e1 * bfhi(b.z) + e2 * bfhi(c.z));
            o.w = cvt_pk_bf16(e0 * bflo(a.w) + e1 * bflo(b.w) + e2 * bflo(c.w), e0 * bfhi(a.w) + e1 * bfhi(b.w) + e2 * bfhi(c.w));
            *(u32x4*)(proj + t * PLD + COL_Q + h * 64 + piece * 8) = o; }
    }
    { float* rowss = (float*)(p.ws + ws_dt(T)); for (size_t i = gtid; i < (size_t)T; i += gn) rowss[i] = 0.f; }
    const int l32 = otid() & 31;
    for (size_t hw0 = gtid >> 5; hw0 < (size_t)T * 8; hw0 += 4 * (gn >> 5)) {
        u32x4 av[4];
#pragma unroll
        for (int q = 0; q < 4; ++q) { const size_t hw = hw0 + q * (gn >> 5); av[q] = *(const u32x4*)(proj + (hw >> 3) * PLD + COL_Z + ((int)hw & 7) * 256 + l32 * 8); }
#pragma unroll
        for (int q = 0; q < 4; ++q) { const size_t hw = hw0 + q * (gn >> 5); const size_t t = hw >> 3; const int g = (int)hw & 7;
            const u32x4 a = av[q];
            float v[8]; v[0] = bflo(a.x); v[1] = bfhi(a.x); v[2] = bflo(a.y); v[3] = bfhi(a.y); v[4] = bflo(a.z); v[5] = bfhi(a.z); v[6] = bflo(a.w); v[7] = bfhi(a.w);
            float ss = 0.f;
#pragma unroll
            for (int e = 0; e < 8; ++e) ss += v[e] * v[e];
            ss += dppf<0xB1>(ss, ss); ss += dppf<0x4E>(ss, ss); ss += dppf<0x141>(ss, ss); ss += dppf<0x140>(ss, ss); ss += __shfl_xor(ss, 16);
            const float rs = rsqrtf(ss * (1.0f / 256.0f) + EPS);
            const float* gp = p.ssd_norm_g + g * 256 + l32 * 8;
            u32x4 o; o.x = cvt_pk_bf16(v[0] * rs * gp[0], v[1] * rs * gp[1]); o.y = cvt_pk_bf16(v[2] * rs * gp[2], v[3] * rs * gp[3]);
            o.z = cvt_pk_bf16(v[4] * rs * gp[4], v[5] * rs * gp[5]); o.w = cvt_pk_bf16(v[6] * rs * gp[6], v[7] * rs * gp[7]);
            *(u32x4*)(proj + t * PLD + COL_Z + g * 256 + l32 * 8) = o; }
    }
}

__device__ __forceinline__ void phase_fixup(const Params& p) {
    const int T = p.T; const bf16_t* side = (const bf16_t*)(p.ws + ws_proj(T) + (size_t)T * 18944); bf16_t* act = (bf16_t*)(p.ws + ws_proj(T) + (size_t)T * 11264);
    const size_t gtid = (size_t)obid() * 512 + otid(), gn = (size_t)gridDim.x * 512;
    for (size_t idx = gtid; idx < (size_t)(T / 64) * 352; idx += gn) {
        const size_t sl = idx / 352; const int cgp = (int)(idx % 352); const int c0 = cgp * 8; const int tile = c0 >> 7, within = c0 & 127; const int ndg = tile * 256 + within;
        const bool first = ((sl * 64) % SEQ) == 0; const size_t slp = first ? sl : sl - 1;
        const bf16_t* s0 = side + sl * 4 * 5632 + ndg; const bf16_t* sp = side + slp * 4 * 5632 + ndg;
        u32x4 g[4], v[4];
        g[0] = *(const u32x4*)(sp + 2 * 5632); v[0] = *(const u32x4*)(sp + 2 * 5632 + 128);
        g[1] = *(const u32x4*)(sp + 3 * 5632); v[1] = *(const u32x4*)(sp + 3 * 5632 + 128);
        g[2] = *(const u32x4*)(s0); v[2] = *(const u32x4*)(s0 + 128);
        g[3] = *(const u32x4*)(s0 + 5632); v[3] = *(const u32x4*)(s0 + 5632 + 128);
        if (first) { g[0] = (u32x4){0u, 0u, 0u, 0u}; g[1] = g[0]; v[0] = g[0]; v[1] = g[0]; }
        float wg[3][8], wv[3][8], bg[8], bv[8];
#pragma unroll
        for (int i = 0; i < 3; ++i)
#pragma unroll
            for (int e = 0; e < 8; ++e) { wg[i][e] = p.ffn_conv_w[i * 5632 + c0 + e]; wv[i][e] = p.ffn_conv_w[i * 5632 + D_FF + c0 + e]; }
#pragma unroll
        for (int e = 0; e < 8; ++e) { bg[e] = p.ffn_conv_b[c0 + e]; bv[e] = p.ffn_conv_b[D_FF + c0 + e]; }
#pragma unroll
        for (int j = 0; j < 2; ++j) {
            const u32x4 a2 = g[j], a1 = g[j + 1], a0 = g[j + 2], c2 = v[j], c1 = v[j + 1], c0v = v[j + 2];
            float o[8];
#define CG1(e, fa, fb) { const float ug_ = bg[e] + wg[0][e] * fa(a2.fb) + wg[1][e] * fa(a1.fb) + wg[2][e] * fa(a0.fb); const float uv_ = bv[e] + wv[0][e] * fa(c2.fb) + wv[1][e] * fa(c1.fb) + wv[2][e] * fa(c0v.fb); o[e] = siluf_(ug_) * uv_; }
            CG1(0, bflo, x) CG1(1, bfhi, x) CG1(2, bflo, y) CG1(3, bfhi, y) CG1(4, bflo, z) CG1(5, bfhi, z) CG1(6, bflo, w) CG1(7, bfhi, w)
#undef CG1
            u32x4 ow; ow.x = cvt_pk_bf16(o[0], o[1]); ow.y = cvt_pk_bf16(o[2], o[3]); ow.z = cvt_pk_bf16(o[4], o[5]); ow.w = cvt_pk_bf16(o[6], o[7]);
            *(u32x4*)(act + (sl * 64 + j) * D_FF + c0) = ow;
        }
    }
}

#define XB_TMO      128
#define XB_XCNT(j)  (256  + 64 * (j))
#define XB_XSUB(j)  (1280 + 64 * (j))
#define XB_XGEN(j)  (2304 + 64 * (j))
#define XB_TOP      3328
#define XB_TOPGEN   3392
#define XCD_BAR_WORDS 3456
#define XB_SPIN_CAP (1u << 22)
__device__ __forceinline__ unsigned xb_ld(unsigned* p)              { return __hip_atomic_load(p, __ATOMIC_RELAXED, __HIP_MEMORY_SCOPE_AGENT); }
__device__ __forceinline__ unsigned xb_add(unsigned* p, unsigned v) { return __hip_atomic_fetch_add(p, v, __ATOMIC_RELAXED, __HIP_MEMORY_SCOPE_AGENT); }
__device__ __forceinline__ unsigned xb_xcc_id() { return (unsigned)__builtin_amdgcn_s_getreg((3 << 11) | 20) & 0xFu; }
#define XB_SPIN(cond, bar) do { unsigned _sp = 0; while (cond) { __builtin_amdgcn_s_sleep(1); \
    if ((++_sp & 255u) == 0u) { if (xb_ld(&(bar)[XB_TMO])) break; if (_sp > XB_SPIN_CAP) { atomicAdd(&(bar)[XB_TMO], 1u); break; } } } } while (0)
struct XcdBarrier { unsigned* bar; unsigned x; volatile LAS unsigned* st; };
__device__ __forceinline__ XcdBarrier xcd_barrier_post(unsigned* bar, volatile LAS unsigned* st) {
    XcdBarrier b; b.bar = bar; b.x = xb_xcc_id(); b.st = st;
    if (threadIdx.x == 0) (void)xb_add(&bar[XB_XCNT(b.x)], 1u);
    return b;
}
__device__ __forceinline__ void xcd_barrier_complete(unsigned* bar, unsigned x, unsigned& nloc, unsigned& nx) {
    const unsigned G = gridDim.x * gridDim.y * gridDim.z;
    unsigned sum, cnt, mine, sp = 0u;
    for (;;) {
        sum = 0u; cnt = 0u; mine = 0u;
#pragma unroll
        for (unsigned j = 0; j < 16; ++j) { const unsigned c = xb_ld(&bar[XB_XCNT(j)]); sum += c; cnt += (c > 0u) ? 1u : 0u; mine = (j == x) ? c : mine; }
        if (sum == G) break;
        __builtin_amdgcn_s_sleep(1);
        if ((++sp & 255u) == 0u) { if (xb_ld(&bar[XB_TMO])) break; if (sp > XB_SPIN_CAP) { atomicAdd(&bar[XB_TMO], 1u); break; } }
    }
    nloc = mine > 0u ? mine : 1u; nx = cnt > 0u ? cnt : 1u;
}
__device__ __forceinline__ void xcd_barrier(const XcdBarrier& b) {
    asm volatile("s_waitcnt vmcnt(0)" ::: "memory");
    __syncthreads();
    if (threadIdx.x == 0) {
        unsigned* bar = b.bar;
        __builtin_amdgcn_s_waitcnt(0);
        unsigned nloc = b.st[0], nx = b.st[1];
        if (nloc == 0u) { xcd_barrier_complete(bar, b.x, nloc, nx); b.st[0] = nloc; b.st[1] = nx; }
        const unsigned old = xb_add(&bar[XB_XSUB(b.x)], 1u);
        const unsigned gen = old / nloc;
        if (old + 1u == (gen + 1u) * nloc) {
            __builtin_amdgcn_fence(__ATOMIC_RELEASE, "agent");
            asm volatile("s_waitcnt vmcnt(0)" ::: "memory");
            const unsigned og = xb_add(&bar[XB_TOP], 1u);
            const unsigned tg = og / nx;
            if (og + 1u == (tg + 1u) * nx) xb_add(&bar[XB_TOPGEN], 1u);
            else XB_SPIN(xb_ld(&bar[XB_TOPGEN]) == tg, bar);
            __builtin_amdgcn_fence(__ATOMIC_ACQUIRE, "agent");
            xb_add(&bar[XB_XGEN(b.x)], 1u);
            asm volatile("s_waitcnt vmcnt(0)" ::: "memory");
        } else {
            XB_SPIN(xb_ld(&bar[XB_XGEN(b.x)]) == gen, bar);
            __builtin_amdgcn_fence(__ATOMIC_ACQUIRE, "agent");
            asm volatile("s_waitcnt vmcnt(0)" ::: "memory");
        }
    }
    __syncthreads();
}

constexpr int PH_PER_CHUNK = 10;
__global__ void __launch_bounds__(512) fwd_megakernel(Params p_in) {
    extern __shared__ __attribute__((aligned(16))) unsigned char smem[];
    LAS unsigned char* lds = (LAS unsigned char*)smem;
    cg::grid_group grid = cg::this_grid();
    volatile LAS unsigned* xbst = (volatile LAS unsigned*)(lds + LDS_BYTES - 16);
    if (threadIdx.x == 0) { xbst[0] = 0u; xbst[1] = 0u; }
    __syncthreads();
    XcdBarrier xb = xcd_barrier_post((unsigned*)(p_in.ws + WS_BAR), xbst);
#define GRID_SYNC() do { if (p.nchunks < 0) grid.sync(); xcd_barrier(xb); } while (0)
    Params p = p_in;
    for (int ph = p.ph_lo; ph < p.ph_hi; ++ph) {
        { size_t z_ = 0; asm volatile("" : "+s"(p.T), "+s"(z_)); p.ws = p_in.ws + z_; }
        const int T = p.T;
        const int chunk = ph / PH_PER_CHUNK, k = ph % PH_PER_CHUNK;
        const size_t tok0 = (size_t)chunk * T;
        bf16_t* H = (bf16_t*)(p.ws + ws_h(T)); bf16_t* PROJ = (bf16_t*)(p.ws + ws_proj(T));
        bf16_t* U = PROJ; bf16_t* ACT = (bf16_t*)(p.ws + ws_proj(T) + (size_t)T * 11264); bf16_t* X1B = (bf16_t*)(p.ws + ws_proj(T) + (size_t)T * 16896);
        float* xout = p.out + tok0 * 1024; const float* xin = p.x + tok0 * 1024;
        for (int rep = ((p.pad0 >> k) & 1); rep >= 0; --rep) {
        if (rep) { size_t z_ = 0; asm volatile("" : "+s"(p.T), "+s"(z_)); p.ws = p_in.ws + z_; }
        switch (k) {
#ifndef PHASE_MASK
#define PHASE_MASK 1023
#endif
#define EN(k_) if (!((PHASE_MASK >> (k_)) & 1)) break;
        case 0: EN(0) if (chunk == 0) phase_wprep(p, lds); phase_rms(xin, p.norm1_g, H, T); break;
        case 1: EN(1) { EpiInproj E; E.O = PROJ; E.dt = (float*)(p.ws + ws_dt(T)); run_gemm(lds, H, 1024, (const bf16_t*)(p.ws + WS_WIN), T, N_IN_PAD, 1024, E); } break;
        case 2: EN(2) phase_mixer(p, lds, rep, rep ? p.pad1 : 3); break;
        case 3: EN(3) phase_post(p); break;
        case 4: EN(4) { EpiGate<0> E0; E0.O = H; E0.G = PROJ + COL_GS; run_gemm(lds, PROJ + COL_Z, PLD, (const bf16_t*)(p.ws + WS_WSP), T, 1024, 2048, E0);
                  EpiGate<1> E1; E1.O = H; E1.G = PROJ + COL_GA; run_gemm(lds, PROJ + COL_Q, PLD, (const bf16_t*)(p.ws + WS_WAP), T, 1024, 512, E1); } break;
        case 5: EN(5) { EpiOut E; E.dst = xout; E.src = xin; E.xb = X1B; E.rowss = (float*)(p.ws + ws_dt(T)); run_gemm(lds, H, 1024, (const bf16_t*)(p.ws + WS_WOUT), T, 1024, 1024, E); } break;
        case 6: break;
        case 7: EN(7) { EpiUpConv E; E.act = ACT; E.side = (bf16_t*)(p.ws + ws_proj(T) + (size_t)T * 18944); E.rowss = (const float*)(p.ws + ws_dt(T)); E.cw = p.ffn_conv_w; E.cbias = p.ffn_conv_b;
                  run_gemm(lds, X1B, 1024, (const bf16_t*)(p.ws + WS_WUP), T, 5632, 1024, E); } break;
        case 8: EN(8) phase_fixup(p); break;
        case 9: EN(9) { EpiDown E; E.dst = xout; E.xb = X1B; run_gemm(lds, ACT, D_FF, (const bf16_t*)(p.ws + WS_WDN), T, 1024, D_FF, E); } break;
        }
        if (rep) GRID_SYNC();
        }
#ifndef SYNC_REP
#define SYNC_REP 1
#endif
        if (ph + 1 < p.ph_hi && k != PH_PER_CHUNK - 1 && k != 6) for (int sr = 0; sr < SYNC_REP; ++sr) GRID_SYNC();
    }
}

#ifndef MK_PER_PHASE_LAUNCH
#define MK_PER_PHASE_LAUNCH 0
#endif
extern "C" void kernel_launch(void* const* d_in, const int* in_sizes, int n_in, void* d_out, int out_size, void* d_ws, size_t ws_size, hipStream_t stream) {
    static int grid_blocks = 0;
    if (!grid_blocks) {
        int dev = 0, cus = 0, per_cu = 0;
        hipGetDevice(&dev);
        hipDeviceGetAttribute(&cus, hipDeviceAttributeMultiprocessorCount, dev);
        hipFuncSetAttribute((const void*)fwd_megakernel, hipFuncAttributeMaxDynamicSharedMemorySize, LDS_BYTES);
        hipOccupancyMaxActiveBlocksPerMultiprocessor(&per_cu, (const void*)fwd_megakernel, 512, LDS_BYTES);
        if (per_cu < 1) { fprintf(stderr, "occupancy query says %d blocks per CU\n", per_cu); per_cu = 1; }
        grid_blocks = cus * 1;
        (void)hipGetLastError();
    }
    if (hipMemsetAsync((char*)d_ws + WS_BAR, 0, WS_BAR_BYTES, stream) != hipSuccess) fprintf(stderr, "memset of barrier words failed\n");
    Params p{};
    const float** pp = (const float**)&p;
    for (int i = 0; i < 19; ++i) pp[i] = (const float*)d_in[i];
    p.out = (float*)d_out; p.ws = (unsigned char*)d_ws;
    int nb = 8;
    while (nb > 1 && ws_total(nb * SEQ) > ws_size) nb >>= 1;
    p.T = nb * SEQ; p.nchunks = BATCH / nb;
#ifndef DUP_MASK
#define DUP_MASK 0
#endif
#ifndef DUP_WHICH
#define DUP_WHICH 3
#endif
    p.pad0 = DUP_MASK; p.pad1 = DUP_WHICH;
    const int nph = p.nchunks * PH_PER_CHUNK;
#if MK_PER_PHASE_LAUNCH
    for (int ph = 0; ph < nph; ++ph) { p.ph_lo = ph; p.ph_hi = ph + 1; hipLaunchKernelGGL(fwd_megakernel, dim3(grid_blocks), dim3(512), LDS_BYTES, stream, p); }
#else
    p.ph_lo = 0; p.ph_hi = nph;
    void* args[] = {&p};
    hipError_t e = hipLaunchCooperativeKernel((const void*)fwd_megakernel, dim3(grid_blocks), dim3(512), args, LDS_BYTES, stream);
    if (e != hipSuccess) fprintf(stderr, "cooperative launch failed: %s (grid %d)\n", hipGetErrorString(e), grid_blocks);
#endif
}
```

```cpp
#include <hip/hip_runtime.h>
#include <hip/hip_cooperative_groups.h>
#include <cstdio>
#include <cstdint>
namespace cg = cooperative_groups;

namespace pg8 {
#define PG8_LAS __attribute__((address_space(3)))
typedef unsigned short bf16_t;
typedef short bf16x8 __attribute__((ext_vector_type(8)));
typedef float f32x4 __attribute__((ext_vector_type(4)));
typedef float f32x16 __attribute__((ext_vector_type(16)));
typedef unsigned u32x4 __attribute__((ext_vector_type(4)));
typedef unsigned u32x2 __attribute__((ext_vector_type(2)));
constexpr int BM = 256, BK = 64, HALF = 128, HTB = HALF * BK * 2, STAGE_BYTES = 8 * HTB, NXCD = 8, WGM = 8;

__host__ __device__ __forceinline__ int lds_byte(int r, int c) { const int st = (r >> 4) * 2 + (c >> 5), rr = r & 15, cc = c & 31, ob = rr * 64 + cc * 2; return st * 1024 + (ob ^ (((ob >> 9) & 1) << 5)); }
__host__ __device__ __forceinline__ void stage_rc(int b, int& R, int& C) { const int st = b / 1024, sb = b % 1024, swz = sb ^ (((sb >> 9) & 1) << 5); R = (st >> 1) * 16 + swz / 64; C = (st & 1) * 32 + (swz % 64) / 2; }
__host__ __device__ __forceinline__ int perm32(int rho) { const int n = rho >> 4, i = rho & 15; return 8 * (i >> 2) + 4 * n + (i & 3); }

struct Unit { int pm, pn; };
struct Gemm { const bf16_t* A; const bf16_t* Bt; int M, N, K, lda; };

struct StaticOrder {
    int nM, nN, nwg, G, c;
    __host__ __device__ void init(int M, int N, int G_, int c_) { nM = M / BM; nN = N / BM; nwg = nM * nN; G = G_; c = c_; }
    __host__ __device__ bool next(int i, Unit& u) const {
        const long L = (long)i * G + c; if (L >= nwg) return false;
        int wgid = (int)L; { const int q = nwg / NXCD, r = nwg % NXCD, xcd = wgid % NXCD, off = wgid / NXCD; wgid = (xcd < r ? xcd * (q + 1) : r * (q + 1) + (xcd - r) * q) + off; }
        const int nig = WGM * nN, gid = wgid / nig, fm = gid * WGM, gsz = (nM - fm) < WGM ? (nM - fm) : WGM;
        u.pm = fm + ((wgid % nig) % gsz); u.pn = (wgid % nig) / gsz; return true;
    }
    __device__ __forceinline__ void a_ready(const Unit&) const {}
    __device__ __forceinline__ void done(const Unit&) const {}
};

__device__ __forceinline__ unsigned cvt_pk_bf16(float lo, float hi) { unsigned r; asm volatile("v_cvt_pk_bf16_f32 %0, %1, %2" : "=v"(r) : "v"(lo), "v"(hi)); return r; }

template <class Epi, class Sched>
__device__ __forceinline__ void gemm_phase(PG8_LAS unsigned char* lds, const Gemm g, const Sched& S, const Epi& E) {
    int tid_ = threadIdx.x; asm volatile("" : "+v"(tid_));
    const int tid = tid_, wid = __builtin_amdgcn_readfirstlane(tid >> 6), lane = tid & 63, wr = wid >> 2, wc = wid & 3, fr = lane & 15, fq = lane >> 4;
    const int K = g.K, nt = K / BK, lda = g.lda;
    unsigned voffA[2], voffB[2];
#pragma unroll
    for (int i = 0; i < 2; ++i) { int R, C; stage_rc(tid * 16 + i * 8192, R, C); const int Rb = Epi::PERM ? ((R & ~31) + perm32(R & 31)) : R;
        voffA[i] = (unsigned)(R * lda + C) * 2u; voffB[i] = (unsigned)(Rb * K + C) * 2u; }
    const size_t kstep = (size_t)(BK * 2);
    const size_t hstepA = (size_t)HALF * lda * 2, hstepB = (size_t)HALF * K * 2;
    const size_t tstepA = 2 * hstepA, tstepB = 2 * hstepB;
    const unsigned ldsw = (unsigned)wid * 1024u;
    const int aoff = lds_byte(wr * 64 + fr, fq * 8), boff = lds_byte(wc * 32 + fr, fq * 8);
#define PG8_SA(b, h) (((b) * 2 + (h)) * HTB)
#define PG8_SB(b, h) ((4 + (b) * 2 + (h)) * HTB)
#define PG8_STAGE(bufoff, gbase, voff) do { _Pragma("unroll") for (int _i = 0; _i < 2; ++_i) \
        __builtin_amdgcn_global_load_lds((const unsigned*)((const char*)(gbase) + (voff)[_i]), (PG8_LAS unsigned*)(lds + (bufoff) + ldsw + _i * 8192), 16, 0, 0); } while (0)
#define PG8_LDA(dst, b, h) do { _Pragma("unroll") for (int m = 0; m < 4; ++m) _Pragma("unroll") for (int k = 0; k < 2; ++k) dst[m][k] = *(const PG8_LAS bf16x8*)(lds + PG8_SA(b, h) + aoff + m * 2048 + k * 1024); } while (0)
#define PG8_LDB(dst, b, h) do { _Pragma("unroll") for (int n = 0; n < 2; ++n) _Pragma("unroll") for (int k = 0; k < 2; ++k) dst[n][k] = *(const PG8_LAS bf16x8*)(lds + PG8_SB(b, h) + boff + n * 2048 + k * 1024); } while (0)
#define PG8_MMA(ai, bj, At, Bt) do { __builtin_amdgcn_s_setprio(1); _Pragma("unroll") for (int m = 0; m < 4; ++m) _Pragma("unroll") for (int n = 0; n < 2; ++n) _Pragma("unroll") for (int k = 0; k < 2; ++k) \
        acc[ai][bj][m][n] = __builtin_amdgcn_mfma_f32_16x16x32_bf16(Bt[n][k], At[m][k], acc[ai][bj][m][n], 0, 0, 0); __builtin_amdgcn_s_setprio(0); } while (0)
#define PG8_WAIT_V(n) asm volatile("s_waitcnt vmcnt(" #n ")" ::: "memory")
#define PG8_WAIT_L(n) asm volatile("s_waitcnt lgkmcnt(" #n ")" ::: "memory")
#define PG8_BAR __builtin_amdgcn_s_barrier()
#define PG8_SCHED __builtin_amdgcn_sched_barrier(0)
    Unit cur, nxt; int ui = 0;
    if (!S.next(0, cur)) return;
    f32x4 acc[2][2][4][2];
#pragma unroll
    for (int a = 0; a < 2; ++a)
#pragma unroll
        for (int b = 0; b < 2; ++b)
#pragma unroll
            for (int m = 0; m < 4; ++m)
#pragma unroll
                for (int n = 0; n < 2; ++n) acc[a][b][m][n] = (f32x4){0.f, 0.f, 0.f, 0.f};
    bf16x8 At[4][2], B0[2][2], B1[2][2];
    const char* cA = (const char*)g.A + (size_t)cur.pm * tstepA; const char* cB = (const char*)g.Bt + (size_t)cur.pn * tstepB;
    S.a_ready(cur);
    PG8_STAGE(PG8_SB(0, 0), cB, voffB); PG8_STAGE(PG8_SA(0, 0), cA, voffA); PG8_STAGE(PG8_SB(0, 1), cB + hstepB, voffB); PG8_STAGE(PG8_SA(0, 1), cA + hstepA, voffA);
    if (wr == 1) PG8_BAR;
    PG8_WAIT_V(4); PG8_BAR;
    PG8_STAGE(PG8_SB(1, 0), cB + kstep, voffB); PG8_STAGE(PG8_SA(1, 0), cA + kstep, voffA); PG8_STAGE(PG8_SB(1, 1), cB + hstepB + kstep, voffB);
    PG8_WAIT_V(6); PG8_BAR;
    for (;;) {
        const bool has_next = S.next(ui + 1, nxt);
        const char* nA = has_next ? (const char*)g.A + (size_t)nxt.pm * tstepA : cA; const char* nB = has_next ? (const char*)g.Bt + (size_t)nxt.pn * tstepB : cB;
        for (int t = 0; t < nt; t += 2) {
            const bool last = (t == nt - 2);
            const char* a1 = cA + (size_t)(t + 1) * kstep;
            const char* a2 = last ? nA : cA + (size_t)(t + 2) * kstep; const char* b2 = last ? nB : cB + (size_t)(t + 2) * kstep;
            const char* a3 = a2 + kstep; const char* b3 = b2 + kstep;
            if (last && has_next) S.a_ready(nxt);
            PG8_LDB(B0, 0, 0); PG8_SCHED; PG8_LDA(At, 0, 0); PG8_STAGE(PG8_SA(1, 1), a1 + hstepA, voffA);
            PG8_WAIT_L(8); PG8_BAR; PG8_WAIT_L(0); PG8_MMA(0, 0, At, B0); PG8_BAR; PG8_SCHED;
            PG8_LDB(B1, 0, 1); PG8_STAGE(PG8_SB(0, 0), b2, voffB);
            PG8_BAR; PG8_WAIT_L(0); PG8_MMA(0, 1, At, B1); PG8_BAR;
            PG8_LDA(At, 0, 1); PG8_STAGE(PG8_SA(0, 0), a2, voffA);
            PG8_BAR; PG8_WAIT_L(0); PG8_MMA(1, 0, At, B0); PG8_BAR; PG8_SCHED;
            PG8_STAGE(PG8_SB(0, 1), b2 + hstepB, voffB);
            PG8_WAIT_V(6); PG8_BAR; PG8_MMA(1, 1, At, B1); PG8_BAR;
            PG8_LDB(B0, 1, 0); PG8_SCHED; PG8_LDA(At, 1, 0); PG8_STAGE(PG8_SA(0, 1), a2 + hstepA, voffA);
            PG8_WAIT_L(8); PG8_BAR; PG8_WAIT_L(0); PG8_MMA(0, 0, At, B0); PG8_BAR; PG8_SCHED;
            PG8_LDB(B1, 1, 1); PG8_STAGE(PG8_SB(1, 0), b3, voffB);
            PG8_BAR; PG8_WAIT_L(0); PG8_MMA(0, 1, At, B1); PG8_BAR;
            PG8_LDA(At, 1, 1); PG8_STAGE(PG8_SA(1, 0), a3, voffA);
            PG8_BAR; PG8_WAIT_L(0); PG8_MMA(1, 0, At, B0); PG8_BAR; PG8_SCHED;
            PG8_STAGE(PG8_SB(1, 1), b3 + hstepB, voffB);
            PG8_WAIT_V(6); PG8_BAR; PG8_MMA(1, 1, At, B1); PG8_BAR;
        }
        E(acc, cur, wr, wc, fr, fq); S.done(cur);
        if (!has_next) break;
#pragma unroll
        for (int a = 0; a < 2; ++a)
#pragma unroll
            for (int b = 0; b < 2; ++b)
#pragma unroll
                for (int m = 0; m < 4; ++m)
#pragma unroll
                    for (int n = 0; n < 2; ++n) acc[a][b][m][n] = (f32x4){0.f, 0.f, 0.f, 0.f};
        cur = nxt; cA = nA; cB = nB; ++ui;
    }
    PG8_WAIT_V(0);
    if (wr == 0) PG8_BAR;
    PG8_BAR;
#undef PG8_SA
#undef PG8_SB
#undef PG8_STAGE
#undef PG8_LDA
#undef PG8_LDB
#undef PG8_MMA
#undef PG8_WAIT_V
#undef PG8_WAIT_L
#undef PG8_BAR
#undef PG8_SCHED
}
}

using pg8::bf16_t; using pg8::bf16x8; using pg8::f32x4; using pg8::f32x16; using pg8::u32x4; using pg8::u32x2; using pg8::Unit; using pg8::cvt_pk_bf16;
#define LAS __attribute__((address_space(3)))

constexpr int D_MODEL = 1024, SEQ = 4096, BATCH = 16;
constexpr int D_INNER = 2048, SSD_HEADS = 32, D_STATE = 128, CONV_DIM = 4096;
constexpr int D_FF = 2816;
constexpr int N_IN_SRC = 12832;
constexpr int N_IN_MAIN = 12800;
constexpr int N_IN_PAD = 13056;
constexpr int PLD = N_IN_MAIN;
constexpr int COL_Z = 0, COL_XBC = 2048, COL_Q = 6144, COL_GS = 10752, COL_GA = 11776;
constexpr float EPS = 1e-6f;
constexpr int LDS_BYTES = 147456;

constexpr size_t WS_BAR = 0;
constexpr size_t WS_BAR_BYTES = 16384;
constexpr size_t WS_WIN = WS_BAR_BYTES;
constexpr size_t WS_WSP = WS_WIN + (size_t)N_IN_PAD * 1024 * 2;
constexpr size_t WS_WAP = WS_WSP + (size_t)1024 * 2048 * 2;
constexpr size_t WS_WOUT = WS_WAP + (size_t)1024 * 512 * 2;
constexpr size_t WS_WUP = WS_WOUT + (size_t)1024 * 1024 * 2;
constexpr size_t WS_WDN = WS_WUP + (size_t)5632 * 1024 * 2;
constexpr size_t WS_ACT0 = WS_WDN + (size_t)1024 * 2816 * 2;
__host__ __device__ constexpr size_t ws_h(int T) { return WS_ACT0; }
__host__ __device__ constexpr size_t ws_dt(int T) { return ws_h(T) + (size_t)T * 2048; }
__host__ __device__ constexpr size_t ws_lse(int T) { return ws_dt(T) + (size_t)T * 128; }
__host__ __device__ constexpr size_t ws_proj(int T) { return ws_lse(T) + (size_t)T * 96; }
__host__ __device__ constexpr size_t ws_total(int T) { return ws_proj(T) + (size_t)T * 25600; }

struct Params {
    const float* x; const float* norm1_g; const float* w_in; const float* ssd_conv_w; const float* ssd_conv_b;
    const float* dt_bias; const float* a_log; const float* d_skip; const float* ssd_norm_g; const float* w_ssd_proj;
    const float* q_norm_g; const float* k_norm_g; const float* w_attn_proj; const float* w_out; const float* norm2_g;
    const float* w_up; const float* ffn_conv_w; const float* ffn_conv_b; const float* w_down;
    float* out; unsigned char* ws;
    int T, nchunks, ph_lo, ph_hi, pad0, pad1;
};

__device__ __forceinline__ float bf2f(unsigned short b) { return __uint_as_float(((unsigned)b) << 16); }
__device__ __forceinline__ float bflo(unsigned u) { return __uint_as_float(u << 16); }
__device__ __forceinline__ float bfhi(unsigned u) { return __uint_as_float(u & 0xffff0000u); }
__device__ __forceinline__ unsigned short f2bf(float f) { return (unsigned short)(cvt_pk_bf16(f, 0.f) & 0xffffu); }
__device__ __forceinline__ int otid() { int t = threadIdx.x; asm volatile("" : "+v"(t)); return t; }
__device__ __forceinline__ int obid() { int t = blockIdx.x; asm volatile("" : "+s"(t)); return t; }
__device__ __forceinline__ float sigmoidf_(float v) { return __builtin_amdgcn_rcpf(1.0f + __expf(-v)); }
__device__ __forceinline__ float siluf_(float v) { return v * __builtin_amdgcn_rcpf(1.0f + __expf(-v)); }
template <int CTRL> __device__ __forceinline__ float dppf(float old, float src) {
    return __builtin_bit_cast(float, __builtin_amdgcn_update_dpp(__builtin_bit_cast(int, old), __builtin_bit_cast(int, src), CTRL, 0xF, 0xF, false));
}

struct EpiInproj {
    static constexpr bool PERM = true;
    bf16_t* O; float* dt;
    __device__ __forceinline__ void operator()(const f32x4 (&acc)[2][2][4][2], const Unit& u, int wr, int wc, int fr, int fq) const {
        const int row0 = u.pm * 256 + wr * 64 + fr;
        if (u.pn < 50) {
            const int col0 = u.pn * 256 + wc * 32 + 8 * fq;
#pragma unroll
            for (int ai = 0; ai < 2; ++ai)
#pragma unroll
                for (int m = 0; m < 4; ++m) { bf16_t* rowp = O + (size_t)(row0 + ai * 128 + m * 16) * PLD + col0;
#pragma unroll
                    for (int bj = 0; bj < 2; ++bj) { const f32x4 v0 = acc[ai][bj][m][0], v1 = acc[ai][bj][m][1];
                        u32x4 w; w.x = cvt_pk_bf16(v0[0], v0[1]); w.y = cvt_pk_bf16(v0[2], v0[3]); w.z = cvt_pk_bf16(v1[0], v1[1]); w.w = cvt_pk_bf16(v1[2], v1[3]);
                        *(u32x4*)(rowp + bj * 128) = w; } }
        } else if (wc == 0) {
#pragma unroll
            for (int ai = 0; ai < 2; ++ai)
#pragma unroll
                for (int m = 0; m < 4; ++m) { float* rp = dt + (size_t)(row0 + ai * 128 + m * 16) * 32 + 8 * fq;
                    *(f32x4*)(rp) = acc[ai][0][m][0]; *(f32x4*)(rp + 4) = acc[ai][0][m][1]; }
        }
    }
};
template <int MODE  > struct EpiGate {
    static constexpr bool PERM = true;
    bf16_t* O; const bf16_t* G;
    __device__ __forceinline__ void operator()(const f32x4 (&acc)[2][2][4][2], const Unit& u, int wr, int wc, int fr, int fq) const {
        const int row0 = u.pm * 256 + wr * 64 + fr, col0 = u.pn * 256 + wc * 32 + 8 * fq;
#pragma unroll
        for (int ai = 0; ai < 2; ++ai) {
            u32x4 gq[4][2];
#pragma unroll
            for (int m = 0; m < 4; ++m)
#pragma unroll
                for (int bj = 0; bj < 2; ++bj) gq[m][bj] = *(const u32x4*)(G + (size_t)(row0 + ai * 128 + m * 16) * PLD + col0 + bj * 128);
#pragma unroll
            for (int mp = 0; mp < 2; ++mp) {
                u32x4 oq[2][2];
                if (MODE == 1) {
#pragma unroll
                    for (int mm = 0; mm < 2; ++mm)
#pragma unroll
                        for (int bj = 0; bj < 2; ++bj) oq[mm][bj] = *(const u32x4*)(O + (size_t)(row0 + ai * 128 + (mp * 2 + mm) * 16) * 1024 + col0 + bj * 128); }
#pragma unroll
                for (int mm = 0; mm < 2; ++mm)
#pragma unroll
                    for (int bj = 0; bj < 2; ++bj) { const int m = mp * 2 + mm; const size_t row = (size_t)(row0 + ai * 128 + m * 16);
                        const f32x4 v0 = acc[ai][bj][m][0], v1 = acc[ai][bj][m][1]; const u32x4 g4 = gq[m][bj];
                        float r[8];
                        r[0] = v0[0] * sigmoidf_(bflo(g4.x)); r[1] = v0[1] * sigmoidf_(bfhi(g4.x)); r[2] = v0[2] * sigmoidf_(bflo(g4.y)); r[3] = v0[3] * sigmoidf_(bfhi(g4.y));
                        r[4] = v1[0] * sigmoidf_(bflo(g4.z)); r[5] = v1[1] * sigmoidf_(bfhi(g4.z)); r[6] = v1[2] * sigmoidf_(bflo(g4.w)); r[7] = v1[3] * sigmoidf_(bfhi(g4.w));
                        if (MODE == 1) { const u32x4 o = oq[mm][bj];
                            r[0] += bflo(o.x); r[1] += bfhi(o.x); r[2] += bflo(o.y); r[3] += bfhi(o.y); r[4] += bflo(o.z); r[5] += bfhi(o.z); r[6] += bflo(o.w); r[7] += bfhi(o.w); }
                        u32x4 w; w.x = cvt_pk_bf16(r[0], r[1]); w.y = cvt_pk_bf16(r[2], r[3]); w.z = cvt_pk_bf16(r[4], r[5]); w.w = cvt_pk_bf16(r[6], r[7]);
                        *(u32x4*)(O + row * 1024 + col0 + bj * 128) = w; }
            }
        }
    }
};
struct EpiRes {
    static constexpr bool PERM = false;
    float* dst; const float* src;
    __device__ __forceinline__ void operator()(const f32x4 (&acc)[2][2][4][2], const Unit& u, int wr, int wc, int fr, int fq) const {
        const int row0 = u.pm * 256 + wr * 64 + fr, col0 = u.pn * 256 + wc * 32 + 4 * fq;
#pragma unroll
        for (int ai = 0; ai < 2; ++ai)
#pragma unroll
            for (int mp = 0; mp < 2; ++mp) {
                f32x4 sv[2][2][2];
#pragma unroll
                for (int mm = 0; mm < 2; ++mm) { const size_t off = (size_t)(row0 + ai * 128 + (mp * 2 + mm) * 16) * 1024 + col0;
#pragma unroll
                    for (int bj = 0; bj < 2; ++bj)
#pragma unroll
                        for (int n = 0; n < 2; ++n) sv[mm][bj][n] = *(const f32x4*)(src + off + bj * 128 + n * 16); }
#pragma unroll
                for (int mm = 0; mm < 2; ++mm) { const int m = mp * 2 + mm; const size_t off = (size_t)(row0 + ai * 128 + m * 16) * 1024 + col0;
#pragma unroll
                    for (int bj = 0; bj < 2; ++bj)
#pragma unroll
                        for (int n = 0; n < 2; ++n) *(f32x4*)(dst + off + bj * 128 + n * 16) = sv[mm][bj][n] + acc[ai][bj][m][n]; }
            }
    }
};
struct EpiOut {
    static constexpr bool PERM = false;
    float* dst; const float* src; bf16_t* xb; float* rowss;
    __device__ __forceinline__ void operator()(const f32x4 (&acc)[2][2][4][2], const Unit& u, int wr, int wc, int fr, int fq) const {
        const int row0 = u.pm * 256 + wr * 64 + fr, col0 = u.pn * 256 + wc * 32 + 4 * fq;
#pragma unroll
        for (int ai = 0; ai < 2; ++ai)
#pragma unroll
            for (int mp = 0; mp < 2; ++mp) {
                f32x4 sv[2][2][2];
#pragma unroll
                for (int mm = 0; mm < 2; ++mm) { const size_t off = (size_t)(row0 + ai * 128 + (mp * 2 + mm) * 16) * 1024 + col0;
#pragma unroll
                    for (int bj = 0; bj < 2; ++bj)
#pragma unroll
                        for (int n = 0; n < 2; ++n) sv[mm][bj][n] = *(const f32x4*)(src + off + bj * 128 + n * 16); }
#pragma unroll
                for (int mm = 0; mm < 2; ++mm) { const int m = mp * 2 + mm; const int row = row0 + ai * 128 + m * 16; const size_t off = (size_t)row * 1024 + col0; float ss = 0.f;
#pragma unroll
                    for (int bj = 0; bj < 2; ++bj)
#pragma unroll
                        for (int n = 0; n < 2; ++n) { const f32x4 v = sv[mm][bj][n] + acc[ai][bj][m][n];
                            ss += v[0] * v[0] + v[1] * v[1] + v[2] * v[2] + v[3] * v[3];
                            u32x2 o; o.x = cvt_pk_bf16(v[0], v[1]); o.y = cvt_pk_bf16(v[2], v[3]); *(u32x2*)(xb + off + bj * 128 + n * 16) = o; }
                    ss += __shfl_xor(ss, 16); ss += __shfl_xor(ss, 32);
                    if (fq == 0) atomicAdd(rowss + row, ss); }
            }
    }
};
struct EpiDown {
    static constexpr bool PERM = false;
    float* dst; const bf16_t* xb;
    __device__ __forceinline__ void operator()(const f32x4 (&acc)[2][2][4][2], const Unit& u, int wr, int wc, int fr, int fq) const {
        const int row0 = u.pm * 256 + wr * 64 + fr, col0 = u.pn * 256 + wc * 32 + 4 * fq;
#pragma unroll
        for (int ai = 0; ai < 2; ++ai) {
            u32x2 sv[4][2][2];
#pragma unroll
            for (int m = 0; m < 4; ++m) { const size_t off = (size_t)(row0 + ai * 128 + m * 16) * 1024 + col0;
#pragma unroll
                for (int bj = 0; bj < 2; ++bj)
#pragma unroll
                    for (int n = 0; n < 2; ++n) sv[m][bj][n] = *(const u32x2*)(xb + off + bj * 128 + n * 16); }
#pragma unroll
            for (int m = 0; m < 4; ++m) { const size_t off = (size_t)(row0 + ai * 128 + m * 16) * 1024 + col0;
#pragma unroll
                for (int bj = 0; bj < 2; ++bj)
#pragma unroll
                    for (int n = 0; n < 2; ++n) { const u32x2 x2 = sv[m][bj][n]; const f32x4 a = acc[ai][bj][m][n];
                        f32x4 o; o[0] = bflo(x2.x) + a[0]; o[1] = bfhi(x2.x) + a[1]; o[2] = bflo(x2.y) + a[2]; o[3] = bfhi(x2.y) + a[3];
                        *(f32x4*)(dst + off + bj * 128 + n * 16) = o; } }
        }
    }
};
struct EpiUp {
    static constexpr bool PERM = true;
    bf16_t* O; const float* rowss;
    __device__ __forceinline__ void operator()(const f32x4 (&acc)[2][2][4][2], const Unit& u, int wr, int wc, int fr, int fq) const {
        const int row0 = u.pm * 256 + wr * 64 + fr, col0 = u.pn * 256 + wc * 32 + 8 * fq;
        float rs[2][4];
#pragma unroll
        for (int ai = 0; ai < 2; ++ai)
#pragma unroll
            for (int m = 0; m < 4; ++m) rs[ai][m] = rowss[row0 + ai * 128 + m * 16];
#pragma unroll
        for (int ai = 0; ai < 2; ++ai)
#pragma unroll
            for (int m = 0; m < 4; ++m) { bf16_t* rowp = O + (size_t)(row0 + ai * 128 + m * 16) * 5632 + col0; const float r = rsqrtf(rs[ai][m] * (1.0f / 1024.0f) + EPS);
#pragma unroll
                for (int bj = 0; bj < 2; ++bj) { const f32x4 v0 = acc[ai][bj][m][0] * r, v1 = acc[ai][bj][m][1] * r;
                    u32x4 w; w.x = cvt_pk_bf16(v0[0], v0[1]); w.y = cvt_pk_bf16(v0[2], v0[3]); w.z = cvt_pk_bf16(v1[0], v1[1]); w.w = cvt_pk_bf16(v1[2], v1[3]);
                    *(u32x4*)(rowp + bj * 128) = w; } }
    }
};
struct EpiUpConv {
    static constexpr bool PERM = true;
    bf16_t* act; bf16_t* side; const float* rowss; const float* cw; const float* cbias;
    struct W8 { f32x4 wg[3], wv[3], bg, bv; };
    __device__ __forceinline__ void loadw(W8& w, int c) const {
#pragma unroll
        for (int i = 0; i < 3; ++i) { w.wg[i] = *(const f32x4*)(cw + i * 5632 + c); w.wv[i] = *(const f32x4*)(cw + i * 5632 + D_FF + c); }
        w.bg = *(const f32x4*)(cbias + c); w.bv = *(const f32x4*)(cbias + D_FF + c);
    }
    template <int N> __device__ __forceinline__ void half(const f32x4 (&acc)[2][2][4][2], const W8& w, const float (&rs)[2][4], int ai, const Unit& u, int wr, int wc, int fr, int fq) const {
        const int row0 = u.pm * 256 + wr * 64 + fr; const int cu = u.pn * 128 + wc * 32 + 8 * fq + 4 * N; const int nd0 = u.pn * 256 + wc * 32 + 8 * fq + 4 * N;
        const int slab = u.pm * 4 + ai * 2 + wr;
        f32x4 pg = (f32x4){0.f, 0.f, 0.f, 0.f}, pv = pg;
#pragma unroll
        for (int m = 0; m < 4; ++m) {
            const float r = rsqrtf(rs[ai][m] * (1.0f / 1024.0f) + EPS);
            const f32x4 ug = acc[ai][0][m][N] * r, uv = acc[ai][1][m][N] * r;
            float o[4];
#pragma unroll
            for (int e = 0; e < 4; ++e) {
                const float g1 = dppf<0x111>(dppf<0x121>(pg[e], pg[e]), ug[e]), g2 = dppf<0x112>(dppf<0x122>(pg[e], pg[e]), ug[e]);
                const float v1 = dppf<0x111>(dppf<0x121>(pv[e], pv[e]), uv[e]), v2 = dppf<0x112>(dppf<0x122>(pv[e], pv[e]), uv[e]);
                const float cg = w.bg[e] + w.wg[0][e] * g2 + w.wg[1][e] * g1 + w.wg[2][e] * ug[e];
                const float cv = w.bv[e] + w.wv[0][e] * v2 + w.wv[1][e] * v1 + w.wv[2][e] * uv[e];
                o[e] = siluf_(cg) * cv; }
            const size_t row = (size_t)(row0 + ai * 128 + m * 16);
            if (m > 0 || fr >= 2) { u32x2 ow; ow.x = cvt_pk_bf16(o[0], o[1]); ow.y = cvt_pk_bf16(o[2], o[3]); *(u32x2*)(act + row * D_FF + cu) = ow; }
            if ((m == 0 && fr < 2) || (m == 3 && fr >= 14)) { const int which = m == 0 ? fr : fr - 12;
                bf16_t* sp = side + ((size_t)slab * 4 + which) * 5632 + nd0;
                u32x2 a; a.x = cvt_pk_bf16(ug[0], ug[1]); a.y = cvt_pk_bf16(ug[2], ug[3]); *(u32x2*)sp = a;
                u32x2 b; b.x = cvt_pk_bf16(uv[0], uv[1]); b.y = cvt_pk_bf16(uv[2], uv[3]); *(u32x2*)(sp + 128) = b; }
            pg = ug; pv = uv;
        }
    }
    __device__ __forceinline__ void operator()(const f32x4 (&acc)[2][2][4][2], const Unit& u, int wr, int wc, int fr, int fq) const {
        const int row0 = u.pm * 256 + wr * 64 + fr; const int cu = u.pn * 128 + wc * 32 + 8 * fq;
        W8 w0, w1; loadw(w0, cu);
        float rs[2][4];
#pragma unroll
        for (int ai = 0; ai < 2; ++ai)
#pragma unroll
            for (int m = 0; m < 4; ++m) rs[ai][m] = rowss[row0 + ai * 128 + m * 16];
        half<0>(acc, w0, rs, 0, u, wr, wc, fr, fq);
        loadw(w1, cu + 4);
        half<0>(acc, w0, rs, 1, u, wr, wc, fr, fq);
        half<1>(acc, w1, rs, 0, u, wr, wc, fr, fq);
        half<1>(acc, w1, rs, 1, u, wr, wc, fr, fq);
    }
};
struct EpiBf16 {
    static constexpr bool PERM = true;
    bf16_t* O; int ldc;
    __device__ __forceinline__ void operator()(const f32x4 (&acc)[2][2][4][2], const Unit& u, int wr, int wc, int fr, int fq) const {
        const int row0 = u.pm * 256 + wr * 64 + fr, col0 = u.pn * 256 + wc * 32 + 8 * fq;
#pragma unroll
        for (int ai = 0; ai < 2; ++ai)
#pragma unroll
            for (int m = 0; m < 4; ++m) { bf16_t* rowp = O + (size_t)(row0 + ai * 128 + m * 16) * ldc + col0;
#pragma unroll
                for (int bj = 0; bj < 2; ++bj) { const f32x4 v0 = acc[ai][bj][m][0], v1 = acc[ai][bj][m][1];
                    u32x4 w; w.x = cvt_pk_bf16(v0[0], v0[1]); w.y = cvt_pk_bf16(v0[2], v0[3]); w.z = cvt_pk_bf16(v1[0], v1[1]); w.w = cvt_pk_bf16(v1[2], v1[3]);
                    *(u32x4*)(rowp + bj * 128) = w; } }
    }
};
template <class Epi> __device__ __forceinline__ void run_gemm(LAS unsigned char* lds, const bf16_t* A, int lda, const bf16_t* Bt, int M, int N, int K, const Epi& E) {
    pg8::Gemm g; g.A = A; g.Bt = Bt; g.M = M; g.N = N; g.K = K; g.lda = lda;
    pg8::StaticOrder S; S.init(M, N, (int)gridDim.x, obid());
    pg8::gemm_phase<Epi, pg8::StaticOrder>(lds, g, S, E);
}

__device__ __forceinline__ void wprep_tile(const float* __restrict__ src, int Nsrc, int K, bf16_t* __restrict__ dst, int tn, int tk, int mode, LAS float* tl, const float* __restrict__ kscale = nullptr) {
    const int tid = otid(); const int nd0 = tn * 64, k0 = tk * 64;
    { const int nn = tid & 63; const int nd = nd0 + nn; int ns = nd;
      if (mode == 1) { if (nd < 6144) ns = nd; else if (nd < N_IN_MAIN) ns = nd + 32; else if (nd < N_IN_MAIN + 32) ns = 6144 + (nd - N_IN_MAIN); else ns = -1; }
      if (mode == 2) { const int tile = nd >> 8, within = nd & 255; ns = within < 128 ? tile * 128 + within : D_FF + tile * 128 + (within - 128); }
#pragma unroll
      for (int it = 0; it < 8; ++it) { const int kk = it * 8 + (tid >> 6); tl[kk * 65 + nn] = ns >= 0 ? src[(size_t)(k0 + kk) * Nsrc + ns] : 0.f; } }
    __syncthreads();
    { const int kk = tid & 63; const float ksc = kscale ? kscale[k0 + kk] : 1.0f;
#pragma unroll
      for (int it = 0; it < 8; ++it) { const int nn = it * 8 + (tid >> 6); dst[(size_t)(nd0 + nn) * K + k0 + kk] = f2bf(tl[kk * 65 + nn] * ksc); } }
    __syncthreads();
}
__device__ __forceinline__ void phase_wprep(const Params& p, LAS unsigned char* lds) {
    LAS float* tl = (LAS float*)lds;
    constexpr int n0 = 204 * 16, n1 = n0 + 16 * 32, n2 = n1 + 16 * 8, n3 = n2 + 16 * 16, n4 = n3 + 88 * 16, n5 = n4 + 16 * 44;
    for (int t = obid(); t < n5; t += gridDim.x) {
        if (t < n0) wprep_tile(p.w_in, N_IN_SRC, 1024, (bf16_t*)(p.ws + WS_WIN), t / 16, t % 16, 1, tl);
        else if (t < n1) { const int q = t - n0; wprep_tile(p.w_ssd_proj, 1024, 2048, (bf16_t*)(p.ws + WS_WSP), q / 32, q % 32, 0, tl); }
        else if (t < n2) { const int q = t - n1; wprep_tile(p.w_attn_proj, 1024, 512, (bf16_t*)(p.ws + WS_WAP), q / 8, q % 8, 0, tl); }
        else if (t < n3) { const int q = t - n2; wprep_tile(p.w_out, 1024, 1024, (bf16_t*)(p.ws + WS_WOUT), q / 16, q % 16, 0, tl); }
        else if (t < n4) { const int q = t - n3; wprep_tile(p.w_up, 5632, 1024, (bf16_t*)(p.ws + WS_WUP), q / 16, q % 16, 2, tl, p.norm2_g); }
        else { const int q = t - n4; wprep_tile(p.w_down, 1024, 2816, (bf16_t*)(p.ws + WS_WDN), q / 44, q % 44, 0, tl); }
    }
}

__device__ __forceinline__ void phase_rms(const float* __restrict__ src, const float* __restrict__ g, bf16_t* __restrict__ dst, int T) {
    const int tid = otid(), w = tid >> 6, lane = tid & 63;
    f32x4 gv[4];
#pragma unroll
    for (int i = 0; i < 4; ++i) gv[i] = *(const f32x4*)(g + i * 256 + lane * 4);
    const int rstride = (int)gridDim.x * 8;
    for (int row0 = obid() * 8 + w; row0 < T; row0 += 4 * rstride) {
        f32x4 v[4][4]; float ss[4];
#pragma unroll
        for (int q = 0; q < 4; ++q) { const int row = row0 + q * rstride < T ? row0 + q * rstride : row0; const float* rp = src + (size_t)row * 1024;
#pragma unroll
            for (int i = 0; i < 4; ++i) v[q][i] = *(const f32x4*)(rp + i * 256 + lane * 4); }
#pragma unroll
        for (int q = 0; q < 4; ++q) { float s1 = 0.f;
#pragma unroll
            for (int i = 0; i < 4; ++i) s1 += v[q][i][0] * v[q][i][0] + v[q][i][1] * v[q][i][1] + v[q][i][2] * v[q][i][2] + v[q][i][3] * v[q][i][3];
            ss[q] = s1; }
#pragma unroll
        for (int o = 32; o >= 1; o >>= 1) {
#pragma unroll
            for (int q = 0; q < 4; ++q) ss[q] += __shfl_xor(ss[q], o); }
#pragma unroll
        for (int q = 0; q < 4; ++q) { const int row = row0 + q * rstride; if (row >= T) break;
            const float rs = rsqrtf(ss[q] * (1.0f / 1024.0f) + EPS);
            bf16_t* op = dst + (size_t)row * 1024;
#pragma unroll
            for (int i = 0; i < 4; ++i) { u32x2 o; o.x = cvt_pk_bf16(v[q][i][0] * rs * gv[i][0], v[q][i][1] * rs * gv[i][1]); o.y = cvt_pk_bf16(v[q][i][2] * rs * gv[i][2], v[q][i][3] * rs * gv[i][3]);
                *(u32x2*)(op + i * 256 + lane * 4) = o; } }
    }
}

constexpr int SLD = 136;
constexpr int L_CM = 0, L_BM = 34816, L_BT = 69632, L_XT = 104448, L_SB = 121856, L_FA = 139264;
__device__ __forceinline__ f32x16 mma32_k(const LAS bf16_t* A, const LAS bf16_t* B, int ksteps, f32x16 acc, int lane) {
    const LAS bf16_t* ap = A + (lane & 31) * SLD + (lane >> 5) * 8; const LAS bf16_t* bp = B + (lane & 31) * SLD + (lane >> 5) * 8;
    for (int ks = 0; ks < ksteps; ks += 2) {
        const bf16x8 a0 = *(const LAS bf16x8*)(ap + ks * 16), a1 = *(const LAS bf16x8*)(ap + ks * 16 + 16);
        const bf16x8 b0 = *(const LAS bf16x8*)(bp + ks * 16), b1 = *(const LAS bf16x8*)(bp + ks * 16 + 16);
        acc = __builtin_amdgcn_mfma_f32_32x32x16_bf16(a0, b0, acc, 0, 0, 0);
        acc = __builtin_amdgcn_mfma_f32_32x32x16_bf16(a1, b1, acc, 0, 0, 0); }
    return acc;
}
__device__ __forceinline__ f32x16 mma32_k8(const LAS bf16_t* A, const LAS bf16_t* B, f32x16 acc, int lane) {
    const LAS bf16_t* ap = A + (lane & 31) * SLD + (lane >> 5) * 8; const LAS bf16_t* bp = B + (lane & 31) * SLD + (lane >> 5) * 8;
#pragma unroll
    for (int h = 0; h < 2; ++h) {
        bf16x8 a[4], b[4];
#pragma unroll
        for (int ks = 0; ks < 4; ++ks) { a[ks] = *(const LAS bf16x8*)(ap + (h * 4 + ks) * 16); b[ks] = *(const LAS bf16x8*)(bp + (h * 4 + ks) * 16); }
#pragma unroll
        for (int ks = 0; ks < 4; ++ks) acc = __builtin_amdgcn_mfma_f32_32x32x16_bf16(a[ks], b[ks], acc, 0, 0, 0);
    }
    return acc;
}
__device__ __forceinline__ void ssd_item(const Params& p, LAS unsigned char* lds, int bl, int head, int dry) {
    const int tid = otid(), w = tid >> 6, lane = tid & 63; const int T = p.T;
    bf16_t* proj = (bf16_t*)(p.ws + ws_proj(T)); const float* dtraw = (const float*)(p.ws + ws_dt(T));
    LAS bf16_t* CM = (LAS bf16_t*)(lds + L_CM); LAS bf16_t* BMm = (LAS bf16_t*)(lds + L_BM); LAS bf16_t* BT = (LAS bf16_t*)(lds + L_BT);
    LAS bf16_t* XT = (LAS bf16_t*)(lds + L_XT); LAS bf16_t* SB = (LAS bf16_t*)(lds + L_SB);
    LAS float* fs = (LAS float*)(lds + L_FA);
    const float Ah = -__expf(p.a_log[head]), Dh = p.d_skip[head], dtb = p.dt_bias[head];
    const int g = head >> 2; const size_t rowbase = (size_t)bl * SEQ;
    const int pt = w >> 2, nt = w & 3;
    const int rsub = 4 * (lane >> 5), cl = lane & 31;
    const bool cact = tid < 320; const int cq = tid % 80, rg = (tid / 80) & 3, rgc = tid < 320 ? tid / 80 : 3;
    int kind, n4, col, ch;
    if (cq < 16) { kind = 0; n4 = 4 * cq; col = COL_XBC + head * 64 + n4; ch = head * 64 + n4; }
    else if (cq < 48) { kind = 1; n4 = 4 * (cq - 16); col = COL_XBC + 2048 + g * 128 + n4; ch = 2048 + g * 128 + n4; }
    else { kind = 2; n4 = 4 * (cq - 48); col = COL_XBC + 3072 + g * 128 + n4; ch = 3072 + g * 128 + n4; }
    f32x4 cw0, cw1, cw2, cw3, cbv;
    cw0 = *(const f32x4*)(p.ssd_conv_w + ch); cw1 = *(const f32x4*)(p.ssd_conv_w + CONV_DIM + ch); cw2 = *(const f32x4*)(p.ssd_conv_w + 2 * CONV_DIM + ch); cw3 = *(const f32x4*)(p.ssd_conv_w + 3 * CONV_DIM + ch);
    cbv = *(const f32x4*)(p.ssd_conv_b + ch);
    u32x2 raw[35]; float dtn0 = 0.f, dtn1 = 0.f; u32x2 zr[4];
    const size_t pstep = cact ? (size_t)PLD : (size_t)0;
    const int ti_d = w >> 1, pc_d = w & 1;
#define SSD_ISSUE_DT(c_) do { const int c__ = (c_); const float* dp = dtraw + (rowbase + (size_t)c__ * 128 + lane) * 32 + head; dtn0 = dp[0]; dtn1 = dp[64 * 32]; } while (0)
#define SSD_ISSUE_RAW(c_) do { const int c__ = (c_); \
        { const int sb__ = cact ? c__ * 128 + rgc * 32 - 3 : 0; const bf16_t* gp = proj + rowbase * PLD + (cact ? col : COL_XBC); \
            _Pragma("unroll") for (int i = 0; i < 3; ++i) { const int sq = sb__ + i; raw[i] = *(const u32x2*)(gp + (size_t)(sq < 0 ? 0 : sq) * PLD); } \
            const bf16_t* gp3 = gp + (size_t)(sb__ + 3) * PLD; \
            _Pragma("unroll") for (int i = 3; i < 35; ++i) raw[i] = *(const u32x2*)(gp3 + (size_t)(i - 3) * pstep); } } while (0)
#define SSD_SCAN(c_) do { const int par__ = (c_) & 1; LAS float* f__ = fs + par__ * 384; \
        float v0 = dtn0 + dtb, v1 = dtn1 + dtb; const float d0 = v0 > 20.f ? v0 : log1pf(__expf(v0)), d1 = v1 > 20.f ? v1 : log1pf(__expf(v1)); \
        float s0 = d0 * Ah, s1 = d1 * Ah; \
        _Pragma("unroll") for (int o = 1; o < 64; o <<= 1) { const float t0 = __shfl_up(s0, o), t1 = __shfl_up(s1, o); if (lane >= o) { s0 += t0; s1 += t1; } } \
        s1 += __shfl(s0, 63); const float cl__ = __shfl(s1, 63); \
        f__[lane] = s0; f__[64 + lane] = s1; f__[128 + lane] = d0; f__[192 + lane] = d1; f__[256 + lane] = __expf(cl__ - s0); f__[320 + lane] = __expf(cl__ - s1); } while (0)
    SSD_ISSUE_DT(0); SSD_ISSUE_RAW(0);
    if (w == 3) SSD_SCAN(0);
    f32x16 accS;
#pragma unroll
    for (int i = 0; i < 16; ++i) accS[i] = 0.f;
    for (int c = 0; c < 32; ++c) {
        const size_t r0 = rowbase + (size_t)c * 128;
        LAS float* fcs = fs + (c & 1) * 384; LAS float* fdt = fcs + 128; LAS float* fwl = fcs + 256;
        __syncthreads();
#pragma unroll
        for (int r = 0; r < 16; ++r) { const int row = (r & 3) + 8 * (r >> 2) + rsub; SB[(pt * 32 + row) * SLD + nt * 32 + cl] = f2bf(accS[r]); }
        { const bf16_t* zp = proj + (r0 + ti_d * 32 + cl) * PLD + COL_Z + head * 64 + pc_d * 32 + rsub;
#pragma unroll
          for (int g4 = 0; g4 < 4; ++g4) zr[g4] = *(const u32x2*)(zp + 8 * g4); }
        SSD_ISSUE_DT(c + 1 < 32 ? c + 1 : 31);
        __builtin_amdgcn_sched_barrier(0);
        if (cact) {
            if (c == 0 && rg == 0) { raw[0] = (u32x2){0u, 0u}; raw[1] = (u32x2){0u, 0u}; raw[2] = (u32x2){0u, 0u}; }
#pragma unroll
            for (int seg = 0; seg < 4; ++seg) {
                float val[8][4];
#pragma unroll
                for (int j = 0; j < 8; ++j) { const int i = seg * 8 + j;
                    const u32x2 x0 = raw[i], x1 = raw[i + 1], x2 = raw[i + 2], x3 = raw[i + 3];
                    float v0 = cbv[0] + cw0[0] * bflo(x0.x) + cw1[0] * bflo(x1.x) + cw2[0] * bflo(x2.x) + cw3[0] * bflo(x3.x);
                    float v1 = cbv[1] + cw0[1] * bfhi(x0.x) + cw1[1] * bfhi(x1.x) + cw2[1] * bfhi(x2.x) + cw3[1] * bfhi(x3.x);
                    float v2 = cbv[2] + cw0[2] * bflo(x0.y) + cw1[2] * bflo(x1.y) + cw2[2] * bflo(x2.y) + cw3[2] * bflo(x3.y);
                    float v3 = cbv[3] + cw0[3] * bfhi(x0.y) + cw1[3] * bfhi(x1.y) + cw2[3] * bfhi(x2.y) + cw3[3] * bfhi(x3.y);
                    val[j][0] = siluf_(v0); val[j][1] = siluf_(v1); val[j][2] = siluf_(v2); val[j][3] = siluf_(v3); }
                const int lb = rg * 32 + seg * 8;
                if (kind != 0) { LAS bf16_t* rm = (kind == 1 ? BMm : CM) + lb * SLD + n4;
#pragma unroll
                    for (int j = 0; j < 8; ++j) { u32x2 o; o.x = cvt_pk_bf16(val[j][0], val[j][1]); o.y = cvt_pk_bf16(val[j][2], val[j][3]); *(LAS u32x2*)(rm + j * SLD) = o; } }
                if (kind != 2) { LAS float* sc = (kind == 0 ? fdt : fwl) + lb; LAS bf16_t* tp = (kind == 0 ? XT : BT) + n4 * SLD + lb;
                    float scl[8];
#pragma unroll
                    for (int j = 0; j < 8; ++j) scl[j] = sc[j];
#pragma unroll
                    for (int e = 0; e < 4; ++e) { u32x4 o; o.x = cvt_pk_bf16(val[0][e] * scl[0], val[1][e] * scl[1]); o.y = cvt_pk_bf16(val[2][e] * scl[2], val[3][e] * scl[3]);
                        o.z = cvt_pk_bf16(val[4][e] * scl[4], val[5][e] * scl[5]); o.w = cvt_pk_bf16(val[6][e] * scl[6], val[7][e] * scl[7]); *(LAS u32x4*)(tp + e * SLD) = o; } }
            }
        }
        SSD_ISSUE_RAW(c + 1 < 32 ? c + 1 : 31);
        __syncthreads();
        f32x16 cb[2]; int ti[2], tj[2];
#pragma unroll
        for (int q = 0; q < 2; ++q) { const int id = w + 8 * q; ti[q] = id >> 2; tj[q] = id & 3;
#pragma unroll
            for (int i = 0; i < 16; ++i) cb[q][i] = 0.f;
            if (tj[q] <= ti[q]) cb[q] = mma32_k8(CM + ti[q] * 32 * SLD, BMm + tj[q] * 32 * SLD, cb[q], lane); }
        __syncthreads();
#pragma unroll
        for (int q = 0; q < 2; ++q) if (tj[q] <= ti[q]) {
            const int s = tj[q] * 32 + cl; const float css = fcs[s];
#pragma unroll
            for (int r = 0; r < 16; ++r) { const int l = ti[q] * 32 + (r & 3) + 8 * (r >> 2) + rsub;
                const float mv = (s <= l) ? cb[q][r] * __expf(fcs[l] - css) : 0.f; BMm[l * SLD + s] = f2bf(mv); } }
        if (w == 3 && c + 1 < 32) SSD_SCAN(c + 1);
        __syncthreads();
        { const int i = ti_d, pc = pc_d;
          f32x16 accd, acco;
#pragma unroll
          for (int r = 0; r < 16; ++r) { accd[r] = 0.f; acco[r] = 0.f; }
          accd = mma32_k(XT + pc * 32 * SLD, BMm + i * 32 * SLD, 2 * (i + 1), accd, lane);
          acco = mma32_k8(SB + pc * 32 * SLD, CM + i * 32 * SLD, acco, lane);
          const int l = i * 32 + cl; const float ecs = __expf(fcs[l]), dsc = Dh * __builtin_amdgcn_rcpf(fdt[l]);
          bf16_t* zp = proj + (r0 + l) * PLD + COL_Z + head * 64 + pc * 32 + rsub;
#pragma unroll
          for (int g4 = 0; g4 < 4; ++g4) { float y[4];
#pragma unroll
              for (int e = 0; e < 4; ++e) { const int pp = pc * 32 + 8 * g4 + rsub + e; y[e] = accd[g4 * 4 + e] + ecs * acco[g4 * 4 + e] + dsc * bf2f(XT[pp * SLD + l]); }
              const u32x2 z2 = zr[g4];
              y[0] *= siluf_(bflo(z2.x)); y[1] *= siluf_(bfhi(z2.x)); y[2] *= siluf_(bflo(z2.y)); y[3] *= siluf_(bfhi(z2.y));
              u32x2 o; o.x = cvt_pk_bf16(y[0], y[1]); o.y = cvt_pk_bf16(y[2], y[3]);
              if (!dry) *(u32x2*)(zp + 8 * g4) = o; } }
        { const float cd = __expf(fcs[127]);
#pragma unroll
          for (int r = 0; r < 16; ++r) accS[r] *= cd;
          accS = mma32_k8(XT + pt * 32 * SLD, BT + nt * 32 * SLD, accS, lane); }
    }
    __syncthreads();
#undef SSD_ISSUE_DT
#undef SSD_ISSUE_RAW
#undef SSD_SCAN
}

constexpr int KLD = 72, VLD = 392; constexpr int L_KS = 0, L_VT = 384 * KLD * 2;
struct AttnItem { size_t rowbase; int gi, h, r, nbk0, d, qcol; };
__device__ __forceinline__ AttnItem attn_decode(int a) {
    AttnItem I; I.h = a & 7; const int j = (a & 127) >> 3; const int gb = a >> 7; const int bl = gb / 3; I.gi = gb - bl * 3;
    const int lg = I.gi * 2; I.d = 1 << lg; I.r = j & (I.d - 1); I.nbk0 = (j >> lg) * 2; I.rowbase = (size_t)bl * SEQ; I.qcol = COL_Q + I.gi * 512 + I.h * 64; return I;
}
__device__ __forceinline__ void attn_load(const bf16_t* proj, const AttnItem& I, int tid, u32x4 (&kr)[6], u32x4 (&vr)[6], u32x4 (&qr)[2][2]) {
    const int piece = tid & 7, w = tid >> 6, lane = tid & 63;
#pragma unroll
    for (int it = 0; it < 6; ++it) { const int kk = it * 64 + (tid >> 3); const int km = I.nbk0 * 128 - 128 + kk;
        const size_t tok = I.rowbase + (size_t)(km < 0 ? 0 : km) * I.d + I.r;
        const u32x4 k4 = *(const u32x4*)(proj + tok * PLD + I.qcol + 1536 + piece * 8), v4 = *(const u32x4*)(proj + tok * PLD + I.qcol + 3072 + piece * 8);
        kr[it].x = km < 0 ? 0u : k4.x; kr[it].y = km < 0 ? 0u : k4.y; kr[it].z = km < 0 ? 0u : k4.z; kr[it].w = km < 0 ? 0u : k4.w;
        vr[it].x = km < 0 ? 0u : v4.x; vr[it].y = km < 0 ? 0u : v4.y; vr[it].z = km < 0 ? 0u : v4.z; vr[it].w = km < 0 ? 0u : v4.w; }
#pragma unroll
    for (int blk = 0; blk < 2; ++blk) { const int qq = 16 * w + (lane & 15); const size_t tokq = I.rowbase + (size_t)((I.nbk0 + blk) * 128 + qq) * I.d + I.r;
        qr[blk][0] = *(const u32x4*)(proj + tokq * PLD + I.qcol + 8 * (lane >> 4)); qr[blk][1] = *(const u32x4*)(proj + tokq * PLD + I.qcol + 32 + 8 * (lane >> 4)); }
}
__device__ __forceinline__ void attn_item(const Params& p, LAS unsigned char* lds, const AttnItem& I, const AttnItem& N, u32x4 (&kr)[6], u32x4 (&vr)[6], u32x4 (&qr)[2][2],
                                          const float (&gk)[8], const float (&gq)[2][8], int dry) {
    const int tid = otid(), w = tid >> 6, lane = tid & 63; const int T = p.T;
    bf16_t* proj = (bf16_t*)(p.ws + ws_proj(T)); float* lse = (float*)(p.ws + ws_lse(T));
    LAS bf16_t* KS = (LAS bf16_t*)(lds + L_KS); LAS bf16_t* VT = (LAS bf16_t*)(lds + L_VT);
    const int gi = I.gi, h = I.h, d = I.d, r = I.r; const size_t rowbase = I.rowbase; const int qcol = I.qcol;
    __syncthreads();
    { const int piece = tid & 7;
#pragma unroll
      for (int it = 0; it < 6; ++it) { const int kk = it * 64 + (tid >> 3);
          const u32x4 k4 = kr[it], v4 = vr[it];
          float kf[8]; kf[0] = bflo(k4.x); kf[1] = bfhi(k4.x); kf[2] = bflo(k4.y); kf[3] = bfhi(k4.y); kf[4] = bflo(k4.z); kf[5] = bfhi(k4.z); kf[6] = bflo(k4.w); kf[7] = bfhi(k4.w);
          float ss = 0.f;
#pragma unroll
          for (int e = 0; e < 8; ++e) ss += kf[e] * kf[e];
          ss += dppf<0xB1>(ss, ss); ss += dppf<0x4E>(ss, ss); ss += dppf<0x141>(ss, ss);
          const float rs = rsqrtf(ss * (1.0f / 64.0f) + EPS);
          u32x4 ko; ko.x = cvt_pk_bf16(kf[0] * rs * gk[0], kf[1] * rs * gk[1]); ko.y = cvt_pk_bf16(kf[2] * rs * gk[2], kf[3] * rs * gk[3]);
          ko.z = cvt_pk_bf16(kf[4] * rs * gk[4], kf[5] * rs * gk[5]); ko.w = cvt_pk_bf16(kf[6] * rs * gk[6], kf[7] * rs * gk[7]);
          *(LAS u32x4*)(KS + kk * KLD + piece * 8) = ko;
          LAS bf16_t* vp = VT + (piece * 8) * VLD + kk;
          vp[0] = (bf16_t)(v4.x & 0xffffu); vp[VLD] = (bf16_t)(v4.x >> 16); vp[2 * VLD] = (bf16_t)(v4.y & 0xffffu); vp[3 * VLD] = (bf16_t)(v4.y >> 16);
          vp[4 * VLD] = (bf16_t)(v4.z & 0xffffu); vp[5 * VLD] = (bf16_t)(v4.z >> 16); vp[6 * VLD] = (bf16_t)(v4.w & 0xffffu); vp[7 * VLD] = (bf16_t)(v4.w >> 16); } }
    const int fr = lane & 15, fq = lane >> 4;
    const int qq = 16 * w + fr;
    bf16x8 qf[2][2];
#pragma unroll
    for (int blk = 0; blk < 2; ++blk) { float qv[2][8]; float ss = 0.f;
#pragma unroll
      for (int ks = 0; ks < 2; ++ks) { const u32x4 q4 = qr[blk][ks]; qv[ks][0] = bflo(q4.x); qv[ks][1] = bfhi(q4.x); qv[ks][2] = bflo(q4.y); qv[ks][3] = bfhi(q4.y);
          qv[ks][4] = bflo(q4.z); qv[ks][5] = bfhi(q4.z); qv[ks][6] = bflo(q4.w); qv[ks][7] = bfhi(q4.w);
#pragma unroll
          for (int e = 0; e < 8; ++e) ss += qv[ks][e] * qv[ks][e]; }
      ss += __shfl_xor(ss, 16); ss += __shfl_xor(ss, 32);
      const float rs = rsqrtf(ss * (1.0f / 64.0f) + EPS) * 0.125f;
#pragma unroll
      for (int ks = 0; ks < 2; ++ks) { u32x4 o;
          o.x = cvt_pk_bf16(qv[ks][0] * rs * gq[ks][0], qv[ks][1] * rs * gq[ks][1]); o.y = cvt_pk_bf16(qv[ks][2] * rs * gq[ks][2], qv[ks][3] * rs * gq[ks][3]);
          o.z = cvt_pk_bf16(qv[ks][4] * rs * gq[ks][4], qv[ks][5] * rs * gq[ks][5]); o.w = cvt_pk_bf16(qv[ks][6] * rs * gq[ks][6], qv[ks][7] * rs * gq[ks][7]);
          qf[blk][ks] = __builtin_bit_cast(bf16x8, o); } }
    __syncthreads();
    attn_load(proj, N, tid, kr, vr, qr);
    const int ts = w < 6 ? w : 6;
#pragma unroll
    for (int blk = 0; blk < 2; ++blk) {
        const int nbk = I.nbk0 + blk; const size_t tokq = rowbase + (size_t)(nbk * 128 + qq) * d + r;
        f32x4 s[10]; float mx = -INFINITY;
#pragma unroll
        for (int tt = 0; tt < 10; ++tt) { const int kt = ts + tt; f32x4 a4 = (f32x4){0.f, 0.f, 0.f, 0.f};
#pragma unroll
            for (int ks = 0; ks < 2; ++ks) { const bf16x8 a = *(const LAS bf16x8*)(KS + ((blk * 8 + kt) * 16 + fr) * KLD + ks * 32 + 8 * fq); a4 = __builtin_amdgcn_mfma_f32_16x16x32_bf16(a, qf[blk][ks], a4, 0, 0, 0); }
#pragma unroll
            for (int i = 0; i < 4; ++i) { const int kk = kt * 16 + 4 * fq + i; const int dist = 128 + qq - kk; const int km = nbk * 128 - 128 + kk;
                const bool ok = (dist >= 0) && (dist <= 128) && (km >= 0); a4[i] = ok ? a4[i] : -INFINITY; mx = fmaxf(mx, a4[i]); }
            s[tt] = a4; }
        mx = fmaxf(mx, __shfl_xor(mx, 16)); mx = fmaxf(mx, __shfl_xor(mx, 32));
        float den = 0.f;
#pragma unroll
        for (int tt = 0; tt < 10; ++tt)
#pragma unroll
            for (int i = 0; i < 4; ++i) { const float e = __expf(s[tt][i] - mx); s[tt][i] = e; den += e; }
        den += __shfl_xor(den, 16); den += __shfl_xor(den, 32);
        f32x4 ao[4];
#pragma unroll
        for (int mt = 0; mt < 4; ++mt) ao[mt] = (f32x4){0.f, 0.f, 0.f, 0.f};
#pragma unroll
        for (int kp = 0; kp < 5; ++kp) {
            u32x4 pk; pk.x = cvt_pk_bf16(s[2 * kp][0], s[2 * kp][1]); pk.y = cvt_pk_bf16(s[2 * kp][2], s[2 * kp][3]); pk.z = cvt_pk_bf16(s[2 * kp + 1][0], s[2 * kp + 1][1]); pk.w = cvt_pk_bf16(s[2 * kp + 1][2], s[2 * kp + 1][3]);
            const bf16x8 pb = __builtin_bit_cast(bf16x8, pk);
#pragma unroll
            for (int mt = 0; mt < 4; ++mt) { const LAS bf16_t* vp = VT + (mt * 16 + fr) * VLD + blk * 128 + (ts + 2 * kp) * 16 + 4 * fq;
                const u32x2 lo = *(const LAS u32x2*)vp; const u32x2 hi = *(const LAS u32x2*)(vp + 16);
                u32x4 av; av.x = lo.x; av.y = lo.y; av.z = hi.x; av.w = hi.y;
                ao[mt] = __builtin_amdgcn_mfma_f32_16x16x32_bf16(__builtin_bit_cast(bf16x8, av), pb, ao[mt], 0, 0, 0); } }
        const float inv = __builtin_amdgcn_rcpf(den);
#pragma unroll
        for (int mt = 0; mt < 4; ++mt) { u32x2 o; o.x = cvt_pk_bf16(ao[mt][0] * inv, ao[mt][1] * inv); o.y = cvt_pk_bf16(ao[mt][2] * inv, ao[mt][3] * inv);
            if (!dry) *(u32x2*)(proj + tokq * PLD + qcol + mt * 16 + 4 * fq) = o; }
        if (fq == 0 && !dry) lse[((size_t)gi * T + tokq) * 8 + h] = mx + __logf(den);
    }
}

__device__ __forceinline__ void phase_mixer(const Params& p, LAS unsigned char* lds, int dry, int which) {
    const int nb = p.T / SEQ; const int nssd = nb * SSD_HEADS; const int nattn = nb * 3 * 8 * 16; const int G = (int)gridDim.x;
    int it = obid();
    for (; it < nssd; it += G) { if (which & 1) { const int x8 = it & 7, y8 = it >> 3; ssd_item(p, lds, y8 >> 2, 4 * x8 + (y8 & 3), dry); } }
    if ((which & 2) && it < nssd + nattn) {
        const bf16_t* proj = (const bf16_t*)(p.ws + ws_proj(p.T)); const int tid = otid();
        float gk[8], gq[2][8];
#pragma unroll
        for (int e = 0; e < 8; ++e) { gk[e] = p.k_norm_g[(tid & 7) * 8 + e]; gq[0][e] = p.q_norm_g[8 * ((tid & 63) >> 4) + e]; gq[1][e] = p.q_norm_g[32 + 8 * ((tid & 63) >> 4) + e]; }
        u32x4 kr[6], vr[6], qr[2][2];
        AttnItem I = attn_decode(it - nssd);
        attn_load(proj, I, tid, kr, vr, qr);
        for (; it < nssd + nattn; it += G) {
            const bool has_next = it + G < nssd + nattn;
            const AttnItem N = attn_decode(has_next ? it + G - nssd : it - nssd);
            attn_item(p, lds, I, N, kr, vr, qr, gk, gq, dry);
            I = N;
        }
    }
    __syncthreads();
}

__device__ __forceinline__ void phase_post(const Params& p) {
    const int T = p.T; bf16_t* proj = (bf16_t*)(p.ws + ws_proj(T)); const float* lse = (const float*)(p.ws + ws_lse(T));
    const size_t gtid = (size_t)obid() * 512 + otid(), gn = (size_t)gridDim.x * 512;
    for (size_t idx0 = gtid; idx0 < (size_t)T * 64; idx0 += 4 * gn) {
        u32x4 va[4], vb[4], vc[4]; float l0[4], l1[4], l2[4];
#pragma unroll
        for (int q = 0; q < 4; ++q) { const size_t idx = (idx0 + q * gn < (size_t)T * 64) ? idx0 + q * gn : idx0; const size_t t = idx >> 6; const int h = (int)(idx >> 3) & 7, piece = (int)idx & 7;
            l0[q] = lse[(t) * 8 + h]; l1[q] = lse[((size_t)T + t) * 8 + h]; l2[q] = lse[((size_t)2 * T + t) * 8 + h];
            const bf16_t* bp = proj + t * PLD + COL_Q + h * 64 + piece * 8; va[q] = *(const u32x4*)bp; vb[q] = *(const u32x4*)(bp + 512); vc[q] = *(const u32x4*)(bp + 1024); }
#pragma unroll
        for (int q = 0; q < 4; ++q) { const size_t idx = idx0 + q * gn; if (idx >= (size_t)T * 64) break; const size_t t = idx >> 6; const int h = (int)(idx >> 3) & 7, piece = (int)idx & 7;
            const float m = fmaxf(l0[q], fmaxf(l1[q], l2[q])); float e0 = __expf(l0[q] - m), e1 = __expf(l1[q] - m), e2 = __expf(l2[q] - m); const float inv = __builtin_amdgcn_rcpf(e0 + e1 + e2); e0 *= inv; e1 *= inv; e2 *= inv;
            const u32x4 a = va[q], b = vb[q], c = vc[q];
            u32x4 o;
            o.x = cvt_pk_bf16(e0 * bflo(a.x) + e1 * bflo(b.x) + e2 * bflo(c.x), e0 * bfhi(a.x) + e1 * bfhi(b.x) + e2 * bfhi(c.x));
            o.y = cvt_pk_bf16(e0 * bflo(a.y) + e1 * bflo(b.y) + e2 * bflo(c.y), e0 * bfhi(a.y) + e1 * bfhi(b.y) + e2 * bfhi(c.y));
            o.z = cvt_pk_bf16(e0 * bflo(a.z) + e1 * bflo(b.z) + e2 * bflo(c.z), e0 * bfhi(a.z) + e1 * bfhi(b.z) + e2 * bfhi(c.z));
            o.w = cvt_pk_bf16(e0 * bflo(a.w) + e1 * bflo(b.w) + e2 * bflo(c.w), e0 * bfhi(a.w) + e1 * bfhi(b.w) + e2 * bfhi(c.w));
            *(u32x4*)(proj + t * PLD + COL_Q + h * 64 + piece * 8) = o; }
    }
    { float* rowss = (float*)(p.ws + ws_dt(T)); for (size_t i = gtid; i < (size_t)T; i += gn) rowss[i] = 0.f; }
    const int l32 = otid() & 31;
    for (size_t hw0 = gtid >> 5; hw0 < (size_t)T * 8; hw0 += 4 * (gn >> 5)) {
        u32x4 av[4];
#pragma unroll
        for (int q = 0; q < 4; ++q) { const size_t hw = hw0 + q * (gn >> 5); av[q] = *(const u32x4*)(proj + (hw >> 3) * PLD + COL_Z + ((int)hw & 7) * 256 + l32 * 8); }
#pragma unroll
        for (int q = 0; q < 4; ++q) { const size_t hw = hw0 + q * (gn >> 5); const size_t t = hw >> 3; const int g = (int)hw & 7;
            const u32x4 a = av[q];
            float v[8]; v[0] = bflo(a.x); v[1] = bfhi(a.x); v[2] = bflo(a.y); v[3] = bfhi(a.y); v[4] = bflo(a.z); v[5] = bfhi(a.z); v[6] = bflo(a.w); v[7] = bfhi(a.w);
            float ss = 0.f;
#pragma unroll
            for (int e = 0; e < 8; ++e) ss += v[e] * v[e];
            ss += dppf<0xB1>(ss, ss); ss += dppf<0x4E>(ss, ss); ss += dppf<0x141>(ss, ss); ss += dppf<0x140>(ss, ss); ss += __shfl_xor(ss, 16);
            const float rs = rsqrtf(ss * (1.0f / 256.0f) + EPS);
            const float* gp = p.ssd_norm_g + g * 256 + l32 * 8;
            u32x4 o; o.x = cvt_pk_bf16(v[0] * rs * gp[0], v[1] * rs * gp[1]); o.y = cvt_pk_bf16(v[2] * rs * gp[2], v[3] * rs * gp[3]);
            o.z = cvt_pk_bf16(v[4] * rs * gp[4], v[5] * rs * gp[5]); o.w = cvt_pk_bf16(v[6] * rs * gp[6], v[7] * rs * gp[7]);
            *(u32x4*)(proj + t * PLD + COL_Z + g * 256 + l32 * 8) = o; }
    }
}

__device__ __forceinline__ void phase_fixup(const Params& p) {
    const int T = p.T; const bf16_t* side = (const bf16_t*)(p.ws + ws_proj(T) + (size_t)T * 18944); bf16_t* act = (bf16_t*)(p.ws + ws_proj(T) + (size_t)T * 11264);
    const size_t gtid = (size_t)obid() * 512 + otid(), gn = (size_t)gridDim.x * 512;
    for (size_t idx = gtid; idx < (size_t)(T / 64) * 352; idx += gn) {
        const size_t sl = idx / 352; const int cgp = (int)(idx % 352); const int c0 = cgp * 8; const int tile = c0 >> 7, within = c0 & 127; const int ndg = tile * 256 + within;
        const bool first = ((sl * 64) % SEQ) == 0; const size_t slp = first ? sl : sl - 1;
        const bf16_t* s0 = side + sl * 4 * 5632 + ndg; const bf16_t* sp = side + slp * 4 * 5632 + ndg;
        u32x4 g[4], v[4];
        g[0] = *(const u32x4*)(sp + 2 * 5632); v[0] = *(const u32x4*)(sp + 2 * 5632 + 128);
        g[1] = *(const u32x4*)(sp + 3 * 5632); v[1] = *(const u32x4*)(sp + 3 * 5632 + 128);
        g[2] = *(const u32x4*)(s0); v[2] = *(const u32x4*)(s0 + 128);
        g[3] = *(const u32x4*)(s0 + 5632); v[3] = *(const u32x4*)(s0 + 5632 + 128);
        if (first) { g[0] = (u32x4){0u, 0u, 0u, 0u}; g[1] = g[0]; v[0] = g[0]; v[1] = g[0]; }
        float wg[3][8], wv[3][8], bg[8], bv[8];
#pragma unroll
        for (int i = 0; i < 3; ++i)
#pragma unroll
            for (int e = 0; e < 8; ++e) { wg[i][e] = p.ffn_conv_w[i * 5632 + c0 + e]; wv[i][e] = p.ffn_conv_w[i * 5632 + D_FF + c0 + e]; }
#pragma unroll
        for (int e = 0; e < 8; ++e) { bg[e] = p.ffn_conv_b[c0 + e]; bv[e] = p.ffn_conv_b[D_FF + c0 + e]; }
#pragma unroll
        for (int j = 0; j < 2; ++j) {
            const u32x4 a2 = g[j], a1 = g[j + 1], a0 = g[j + 2], c2 = v[j], c1 = v[j + 1], c0v = v[j + 2];
            float o[8];
#define CG1(e, fa, fb) { const float ug_ = bg[e] + wg[0][e] * fa(a2.fb) + wg[1][e] * fa(a1.fb) + wg[2][e] * fa(a0.fb); const float uv_ = bv[e] + wv[0][e] * fa(c2.fb) + wv[1][e] * fa(c1.fb) + wv[2][e] * fa(c0v.fb); o[e] = siluf_(ug_) * uv_; }
            CG1(0, bflo, x) CG1(1, bfhi, x) CG1(2, bflo, y) CG1(3, bfhi, y) CG1(4, bflo, z) CG1(5, bfhi, z) CG1(6, bflo, w) CG1(7, bfhi, w)
#undef CG1
            u32x4 ow; ow.x = cvt_pk_bf16(o[0], o[1]); ow.y = cvt_pk_bf16(o[2], o[3]); ow.z = cvt_pk_bf16(o[4], o[5]); ow.w = cvt_pk_bf16(o[6], o[7]);
            *(u32x4*)(act + (sl * 64 + j) * D_FF + c0) = ow;
        }
    }
}

#define XB_TMO      128
#define XB_XCNT(j)  (256  + 64 * (j))
#define XB_XSUB(j)  (1280 + 64 * (j))
#define XB_XGEN(j)  (2304 + 64 * (j))
#define XB_TOP      3328
#define XB_TOPGEN   3392
#define XCD_BAR_WORDS 3456
#define XB_SPIN_CAP (1u << 22)
__device__ __forceinline__ unsigned xb_ld(unsigned* p)              { return __hip_atomic_load(p, __ATOMIC_RELAXED, __HIP_MEMORY_SCOPE_AGENT); }
__device__ __forceinline__ unsigned xb_add(unsigned* p, unsigned v) { return __hip_atomic_fetch_add(p, v, __ATOMIC_RELAXED, __HIP_MEMORY_SCOPE_AGENT); }
__device__ __forceinline__ unsigned xb_xcc_id() { return (unsigned)__builtin_amdgcn_s_getreg((3 << 11) | 20) & 0xFu; }
#define XB_SPIN(cond, bar) do { unsigned _sp = 0; while (cond) { __builtin_amdgcn_s_sleep(1); \
    if ((++_sp & 255u) == 0u) { if (xb_ld(&(bar)[XB_TMO])) break; if (_sp > XB_SPIN_CAP) { atomicAdd(&(bar)[XB_TMO], 1u); break; } } } } while (0)
struct XcdBarrier { unsigned* bar; unsigned x; volatile LAS unsigned* st; };
__device__ __forceinline__ XcdBarrier xcd_barrier_post(unsigned* bar, volatile LAS unsigned* st) {
    XcdBarrier b; b.bar = bar; b.x = xb_xcc_id(); b.st = st;
    if (threadIdx.x == 0) (void)xb_add(&bar[XB_XCNT(b.x)], 1u);
    return b;
}
__device__ __forceinline__ void xcd_barrier_complete(unsigned* bar, unsigned x, unsigned& nloc, unsigned& nx) {
    const unsigned G = gridDim.x * gridDim.y * gridDim.z;
    unsigned sum, cnt, mine, sp = 0u;
    for (;;) {
        sum = 0u; cnt = 0u; mine = 0u;
#pragma unroll
        for (unsigned j = 0; j < 16; ++j) { const unsigned c = xb_ld(&bar[XB_XCNT(j)]); sum += c; cnt += (c > 0u) ? 1u : 0u; mine = (j == x) ? c : mine; }
        if (sum == G) break;
        __builtin_amdgcn_s_sleep(1);
        if ((++sp & 255u) == 0u) { if (xb_ld(&bar[XB_TMO])) break; if (sp > XB_SPIN_CAP) { atomicAdd(&bar[XB_TMO], 1u); break; } }
    }
    nloc = mine > 0u ? mine : 1u; nx = cnt > 0u ? cnt : 1u;
}
__device__ __forceinline__ void xcd_barrier(const XcdBarrier& b) {
    asm volatile("s_waitcnt vmcnt(0)" ::: "memory");
    __syncthreads();
    if (threadIdx.x == 0) {
        unsigned* bar = b.bar;
        __builtin_amdgcn_s_waitcnt(0);
        unsigned nloc = b.st[0], nx = b.st[1];
        if (nloc == 0u) { xcd_barrier_complete(bar, b.x, nloc, nx); b.st[0] = nloc; b.st[1] = nx; }
        const unsigned old = xb_add(&bar[XB_XSUB(b.x)], 1u);
        const unsigned gen = old / nloc;
        if (old + 1u == (gen + 1u) * nloc) {
            __builtin_amdgcn_fence(__ATOMIC_RELEASE, "agent");
            asm volatile("s_waitcnt vmcnt(0)" ::: "memory");
            const unsigned og = xb_add(&bar[XB_TOP], 1u);
            const unsigned tg = og / nx;
            if (og + 1u == (tg + 1u) * nx) xb_add(&bar[XB_TOPGEN], 1u);
            else XB_SPIN(xb_ld(&bar[XB_TOPGEN]) == tg, bar);
            __builtin_amdgcn_fence(__ATOMIC_ACQUIRE, "agent");
            xb_add(&bar[XB_XGEN(b.x)], 1u);
            asm volatile("s_waitcnt vmcnt(0)" ::: "memory");
        } else {
            XB_SPIN(xb_ld(&bar[XB_XGEN(b.x)]) == gen, bar);
            __builtin_amdgcn_fence(__ATOMIC_ACQUIRE, "agent");
            asm volatile("s_waitcnt vmcnt(0)" ::: "memory");
        }
    }
    __syncthreads();
}

constexpr int PH_PER_CHUNK = 10;
__global__ void __launch_bounds__(512) fwd_megakernel(Params p_in) {
    extern __shared__ __attribute__((aligned(16))) unsigned char smem[];
    LAS unsigned char* lds = (LAS unsigned char*)smem;
    cg::grid_group grid = cg::this_grid();
    volatile LAS unsigned* xbst = (volatile LAS unsigned*)(lds + LDS_BYTES - 16);
    if (threadIdx.x == 0) { xbst[0] = 0u; xbst[1] = 0u; }
    __syncthreads();
    XcdBarrier xb = xcd_barrier_post((unsigned*)(p_in.ws + WS_BAR), xbst);
#define GRID_SYNC() do { if (p.nchunks < 0) grid.sync(); xcd_barrier(xb); } while (0)
    Params p = p_in;
    for (int ph = p.ph_lo; ph < p.ph_hi; ++ph) {
        { size_t z_ = 0; asm volatile("" : "+s"(p.T), "+s"(z_)); p.ws = p_in.ws + z_; }
        const int T = p.T;
        const int chunk = ph / PH_PER_CHUNK, k = ph % PH_PER_CHUNK;
        const size_t tok0 = (size_t)chunk * T;
        bf16_t* H = (bf16_t*)(p.ws + ws_h(T)); bf16_t* PROJ = (bf16_t*)(p.ws + ws_proj(T));
        bf16_t* U = PROJ; bf16_t* ACT = (bf16_t*)(p.ws + ws_proj(T) + (size_t)T * 11264); bf16_t* X1B = (bf16_t*)(p.ws + ws_proj(T) + (size_t)T * 16896);
        float* xout = p.out + tok0 * 1024; const float* xin = p.x + tok0 * 1024;
        { constexpr int rep = 0;
        switch (k) {
#ifndef PHASE_MASK
#define PHASE_MASK 1023
#endif
#define EN(k_) if (!((PHASE_MASK >> (k_)) & 1)) break;
        case 0: EN(0) if (chunk == 0) phase_wprep(p, lds); phase_rms(xin, p.norm1_g, H, T); break;
        case 1: EN(1) { EpiInproj E; E.O = PROJ; E.dt = (float*)(p.ws + ws_dt(T)); run_gemm(lds, H, 1024, (const bf16_t*)(p.ws + WS_WIN), T, N_IN_PAD, 1024, E); } break;
        case 2: EN(2) phase_mixer(p, lds, rep, rep ? p.pad1 : 3); break;
        case 3: EN(3) phase_post(p); break;
        case 4: EN(4) { EpiGate<0> E0; E0.O = H; E0.G = PROJ + COL_GS; run_gemm(lds, PROJ + COL_Z, PLD, (const bf16_t*)(p.ws + WS_WSP), T, 1024, 2048, E0);
                  EpiGate<1> E1; E1.O = H; E1.G = PROJ + COL_GA; run_gemm(lds, PROJ + COL_Q, PLD, (const bf16_t*)(p.ws + WS_WAP), T, 1024, 512, E1); } break;
        case 5: EN(5) { EpiOut E; E.dst = xout; E.src = xin; E.xb = X1B; E.rowss = (float*)(p.ws + ws_dt(T)); run_gemm(lds, H, 1024, (const bf16_t*)(p.ws + WS_WOUT), T, 1024, 1024, E); } break;
        case 6: break;
        case 7: EN(7) { EpiUpConv E; E.act = ACT; E.side = (bf16_t*)(p.ws + ws_proj(T) + (size_t)T * 18944); E.rowss = (const float*)(p.ws + ws_dt(T)); E.cw = p.ffn_conv_w; E.cbias = p.ffn_conv_b;
                  run_gemm(lds, X1B, 1024, (const bf16_t*)(p.ws + WS_WUP), T, 5632, 1024, E); } break;
        case 8: EN(8) phase_fixup(p); break;
        case 9: EN(9) { EpiDown E; E.dst = xout; E.xb = X1B; run_gemm(lds, ACT, D_FF, (const bf16_t*)(p.ws + WS_WDN), T, 1024, D_FF, E); } break;
        }
        }
#ifndef SYNC_REP
#define SYNC_REP 1
#endif
        if (ph + 1 < p.ph_hi && k != PH_PER_CHUNK - 1 && k != 6) for (int sr = 0; sr < SYNC_REP; ++sr) GRID_SYNC();
    }
}

#ifndef MK_PER_PHASE_LAUNCH
#define MK_PER_PHASE_LAUNCH 0
#endif
extern "C" void kernel_launch(void* const* d_in, const int* in_sizes, int n_in, void* d_out, int out_size, void* d_ws, size_t ws_size, hipStream_t stream) {
    static int grid_blocks = 0;
    if (!grid_blocks) {
        int dev = 0, cus = 0, per_cu = 0;
        hipGetDevice(&dev);
        hipDeviceGetAttribute(&cus, hipDeviceAttributeMultiprocessorCount, dev);
        hipFuncSetAttribute((const void*)fwd_megakernel, hipFuncAttributeMaxDynamicSharedMemorySize, LDS_BYTES);
        hipOccupancyMaxActiveBlocksPerMultiprocessor(&per_cu, (const void*)fwd_megakernel, 512, LDS_BYTES);
        if (per_cu < 1) { fprintf(stderr, "occupancy query says %d blocks per CU\n", per_cu); per_cu = 1; }
        grid_blocks = cus * 1;
        (void)hipGetLastError();
    }
    if (hipMemsetAsync((char*)d_ws + WS_BAR, 0, WS_BAR_BYTES, stream) != hipSuccess) fprintf(stderr, "memset of barrier words failed\n");
    Params p{};
    const float** pp = (const float**)&p;
    for (int i = 0; i < 19; ++i) pp[i] = (const float*)d_in[i];
    p.out = (float*)d_out; p.ws = (unsigned char*)d_ws;
    int nb = 8;
    while (nb > 1 && ws_total(nb * SEQ) > ws_size) nb >>= 1;
    p.T = nb * SEQ; p.nchunks = BATCH / nb;
#ifndef DUP_MASK
#define DUP_MASK 0
#endif
#ifndef DUP_WHICH
#define DUP_WHICH 3
#endif
    p.pad0 = DUP_MASK; p.pad1 = DUP_WHICH;
    const int nph = p.nchunks * PH_PER_CHUNK;
#if MK_PER_PHASE_LAUNCH
    for (int ph = 0; ph < nph; ++ph) { p.ph_lo = ph; p.ph_hi = ph + 1; hipLaunchKernelGGL(fwd_megakernel, dim3(grid_blocks), dim3(512), LDS_BYTES, stream, p); }
#else
    p.ph_lo = 0; p.ph_hi = nph;
    void* args[] = {&p};
    hipError_t e = hipLaunchCooperativeKernel((const void*)fwd_megakernel, dim3(grid_blocks), dim3(512), args, LDS_BYTES, stream);
    if (e != hipSuccess) fprintf(stderr, "cooperative launch failed: %s (grid %d)\n", hipGetErrorString(e), grid_blocks);
#endif
}
```
